# Optimizing an MI355X kernel written in HIP

```python
import jax, jax.numpy as jnp
from jax import lax
import numpy as np

D_MODEL = 1024
BATCH = 8
SEQ = 8192
DEPTH = 4
DEC_BATCH = 16
DEC_SEQ = 32
PAST_LEN = 2048

CHUNK = 64
N_MIXERS = 2
N_SGU_LAYERS = (DEPTH + 1) // 2
N_POOL_LAYERS = DEPTH // 2
D_SGU = 2 * D_MODEL
SGU_GROUPS = 8
SGU_GROUP_DIM = D_SGU // SGU_GROUPS
SGU_LEN = 128
POOL_WINDOWS = (2, 4, 8, 16)
POOL_GROUPS = len(POOL_WINDOWS)
POOL_GROUP_DIM = D_MODEL // POOL_GROUPS
POOL_MAX_W = max(POOL_WINDOWS)
POOL_STATE = POOL_MAX_W - 1
D_FF = 4 * D_MODEL
N_MOD = 6
EPS = 1e-6

kernel_name = "hybrid_sgu_pool_stream_encoder_step"


def rmsnorm(x, g):
    xf = x.astype(jnp.float32)
    y = xf * lax.rsqrt(jnp.mean(xf * xf, axis=-1, keepdims=True) + EPS)
    return (y * g.astype(jnp.float32)).astype(x.dtype)


def sgu_chunk_mask():
    pos = jnp.arange(SGU_LEN)
    return (pos[None, :] // CHUNK) <= (pos[:, None] // CHUNK)


def sgu_mixer(h, w_in, g_v, w_s, b_s, w_out, T):
    bsz, L, _ = h.shape
    z = jax.nn.gelu(h @ w_in)
    u, v = jnp.split(z, 2, axis=-1)
    v = rmsnorm(v, g_v)
    vr = v.reshape(bsz, L // T, T, SGU_GROUPS, SGU_GROUP_DIM)
    w = w_s[:, :T, :T] * sgu_chunk_mask()[:T, :T].astype(w_s.dtype)
    s = jnp.einsum('gij,bnjgd->bnigd', w, vr)
    s = s + jnp.transpose(b_s[:, :T])[None, None, :, :, None]
    s = s.reshape(bsz, L, D_SGU)
    return (u * s) @ w_out, v


def pool_mixer(h_ext, n_out, w_grp, scale):
    bsz, L, _ = h_ext.shape
    hf = h_ext.astype(jnp.float32)
    csum = jnp.pad(jnp.cumsum(hf, axis=1), ((0, 0), (POOL_MAX_W, 0), (0, 0)))
    rows = jnp.arange(L - n_out, L)
    start = POOL_MAX_W + L - n_out
    outs = []
    for g, w in enumerate(POOL_WINDOWS):
        sl = slice(g * POOL_GROUP_DIM, (g + 1) * POOL_GROUP_DIM)
        win = csum[:, start:start + n_out, sl] - csum[:, start - w:start - w + n_out, sl]
        cnt = jnp.minimum(w, rows + 1).astype(jnp.float32)[None, :, None]
        outs.append(win / cnt)
    pooled = jnp.concatenate(outs, axis=-1) - hf[:, L - n_out:]
    pooled = pooled.astype(h_ext.dtype).reshape(bsz, n_out, POOL_GROUPS, POOL_GROUP_DIM)
    y = jnp.einsum('btgc,gcd->btgd', pooled, w_grp).reshape(bsz, n_out, D_MODEL)
    return y * scale


def trunk(x, c, pool_cache, g_norm, w_ada, b_ada, sgu_w_in, sgu_g_v, sgu_w_s, sgu_b_s,
          sgu_w_out, pool_w_grp, pool_scale, ffn_w_up, ffn_w_down):
    sample = pool_cache is not None
    L = x.shape[1]
    sgu_states, pool_states = [], []
    for i in range(DEPTH):
        mod = jax.nn.silu(c) @ w_ada[i] + b_ada[i]
        sh1, sc1, gt1, sh2, sc2, gt2 = jnp.split(mod[:, None, :], N_MOD, axis=-1)
        h = rmsnorm(x, g_norm[i, 0]) * (1 + sc1) + sh1
        j = i // N_MIXERS
        if i % N_MIXERS == 0:
            T = L if sample else SGU_LEN
            mix, v = sgu_mixer(h, sgu_w_in[j], sgu_g_v[j], sgu_w_s[j], sgu_b_s[j], sgu_w_out[j], T)
            if sample:
                sgu_states.append(v)
        else:
            h_ext = jnp.concatenate([pool_cache[j].astype(h.dtype), h], axis=1) if sample else h
            mix = pool_mixer(h_ext, L, pool_w_grp[j], pool_scale[j])
            pool_states.append(h_ext[:, h_ext.shape[1] - POOL_STATE:])
        x = x + gt1 * rmsnorm(mix, g_norm[i, 1])
        h = rmsnorm(x, g_norm[i, 2]) * (1 + sc2) + sh2
        f = jnp.square(jax.nn.relu(h @ ffn_w_up[i])) @ ffn_w_down[i]
        x = x + gt2 * rmsnorm(f, g_norm[i, 3])
    return x, sgu_states, pool_states


def setup_inputs(seed: int = 0) -> dict:
    key = jax.random.key(seed)
    ks = jax.random.split(key, 20)
    f32 = jnp.float32
    nrm = lambda k, shape, s=1.0: (jax.random.normal(k, shape, f32) * s)
    return {
        "x_prompt": nrm(ks[0], (BATCH, SEQ, D_MODEL)),
        "x_sample": nrm(ks[1], (DEC_BATCH, DEC_SEQ, D_MODEL)),
        "cache_pool": nrm(ks[2], (N_POOL_LAYERS, DEC_BATCH, POOL_STATE, D_MODEL)),
        "c_prompt": nrm(ks[3], (BATCH, D_MODEL)),
        "c_sample": nrm(ks[4], (DEC_BATCH, D_MODEL)),
        "g_norm": 1.0 + nrm(ks[5], (DEPTH, 4, D_MODEL), 0.05),
        "w_ada": nrm(ks[6], (DEPTH, D_MODEL, N_MOD * D_MODEL), 0.5 * D_MODEL ** -0.5),
        "b_ada": nrm(ks[7], (DEPTH, N_MOD * D_MODEL), 0.02),
        "sgu_w_in": nrm(ks[8], (N_SGU_LAYERS, D_MODEL, 2 * D_SGU), D_MODEL ** -0.5),
        "sgu_g_v": 1.0 + nrm(ks[9], (N_SGU_LAYERS, D_SGU), 0.05),
        "sgu_w_s": nrm(ks[10], (N_SGU_LAYERS, SGU_GROUPS, SGU_LEN, SGU_LEN), SGU_LEN ** -0.5),
        "sgu_b_s": 1.0 + nrm(ks[11], (N_SGU_LAYERS, SGU_GROUPS, SGU_LEN), 0.1),
        "sgu_w_out": nrm(ks[12], (N_SGU_LAYERS, D_SGU, D_MODEL), D_SGU ** -0.5),
        "pool_w_grp": nrm(ks[13], (N_POOL_LAYERS, POOL_GROUPS, POOL_GROUP_DIM, POOL_GROUP_DIM), POOL_GROUP_DIM ** -0.5),
        "pool_scale": 1.0 + nrm(ks[14], (N_POOL_LAYERS, D_MODEL), 0.1),
        "ffn_w_up": nrm(ks[15], (DEPTH, D_MODEL, D_FF), D_MODEL ** -0.5),
        "ffn_w_down": nrm(ks[16], (DEPTH, D_FF, D_MODEL), D_FF ** -0.5),
    }


def reference(x_prompt, x_sample, cache_pool, c_prompt, c_sample, g_norm, w_ada, b_ada,
              sgu_w_in, sgu_g_v, sgu_w_s, sgu_b_s, sgu_w_out, pool_w_grp, pool_scale,
              ffn_w_up, ffn_w_down):
    y_prompt, _, pool_p = trunk(x_prompt, c_prompt, None, g_norm, w_ada, b_ada, sgu_w_in,
                                sgu_g_v, sgu_w_s, sgu_b_s, sgu_w_out, pool_w_grp, pool_scale,
                                ffn_w_up, ffn_w_down)
    y_sample, sgu_s, pool_s = trunk(x_sample, c_sample, cache_pool, g_norm, w_ada, b_ada, sgu_w_in,
                                    sgu_g_v, sgu_w_s, sgu_b_s, sgu_w_out, pool_w_grp, pool_scale,
                                    ffn_w_up, ffn_w_down)
    state_pool_prompt = jnp.stack(pool_p, axis=0)
    state_sgu_sample = jnp.stack(sgu_s, axis=0)
    state_pool_sample = jnp.stack(pool_s, axis=0)
    return (y_prompt, y_sample, state_pool_prompt, state_sgu_sample, state_pool_sample)
```

```cpp
#include <hip/hip_runtime.h>
#include <hip/hip_cooperative_groups.h>
#include <cstdio>
namespace cg = cooperative_groups;

namespace pg8 {
#define PG8_LAS __attribute__((address_space(3)))
typedef unsigned short bf16_t;
typedef short bf16x8 __attribute__((ext_vector_type(8)));
typedef float f32x4 __attribute__((ext_vector_type(4)));
typedef unsigned u32x4 __attribute__((ext_vector_type(4)));
constexpr int BM = 256, BK = 64, HALF = 128, HTB = HALF * BK * 2  , STAGE_BYTES = 8 * HTB, NXCD = 8, WGM = 8;

__host__ __device__ __forceinline__ int lds_byte(int r, int c) { const int st = (r >> 4) * 2 + (c >> 5), rr = r & 15, cc = c & 31, ob = rr * 64 + cc * 2; return st * 1024 + (ob ^ (((ob >> 9) & 1) << 5)); }
__host__ __device__ __forceinline__ void stage_rc(int b, int& R, int& C) { const int st = b / 1024, sb = b % 1024, swz = sb ^ (((sb >> 9) & 1) << 5); R = (st >> 1) * 16 + swz / 64; C = (st & 1) * 32 + (swz % 64) / 2; }
__host__ __device__ __forceinline__ int perm32(int rho) { const int n = rho >> 4, i = rho & 15; return 8 * (i >> 2) + 4 * n + (i & 3); }

struct Unit { int pm, pn; };
struct Gemm { const bf16_t* A; const bf16_t* Bt; int M, N, K, lda, acol; };

struct StaticOrder {
    int nM, nN, nwg, G, c;
    __host__ __device__ void init(int M, int N, int G_, int c_) { nM = M / BM; nN = N / BM; nwg = nM * nN; G = G_; c = c_; }
    __host__ __device__ bool next(int i, Unit& u) const {
        const long L = (long)i * G + c; if (L >= nwg) return false;
        int wgid = (int)L; { const int q = nwg / NXCD, r = nwg % NXCD, xcd = wgid % NXCD, off = wgid / NXCD; wgid = (xcd < r ? xcd * (q + 1) : r * (q + 1) + (xcd - r) * q) + off; }
        const int nig = WGM * nN, gid = wgid / nig, fm = gid * WGM, gsz = (nM - fm) < WGM ? (nM - fm) : WGM;
        u.pm = fm + ((wgid % nig) % gsz); u.pn = (wgid % nig) / gsz; return true;
    }
    __device__ __forceinline__ void a_ready(const Unit&) const {}
    __device__ __forceinline__ void done(const Unit&) const {}
};

__device__ __forceinline__ unsigned cvt_pk_bf16(float lo, float hi) { unsigned r; asm("v_cvt_pk_bf16_f32 %0, %1, %2" : "=v"(r) : "v"(lo), "v"(hi)); return r; }
template <class Epi, class Sched>
__device__ __forceinline__ void gemm_phase(PG8_LAS unsigned char* lds, const Gemm g, const Sched& S, const Epi& E) {
    int tid_ = threadIdx.x; asm volatile("" : "+v"(tid_));
    const int tid = tid_, wid = __builtin_amdgcn_readfirstlane(tid >> 6), lane = tid & 63, wr = wid >> 2, wc = wid & 3, fr = lane & 15, fq = lane >> 4;
    const int K = g.K, nt = K / BK;
#define PG8_STAMP() do { } while (0)
    PG8_STAMP();
    unsigned voffA[2], voffB[2];
#pragma unroll
    for (int i = 0; i < 2; ++i) { int R, C; stage_rc(tid * 16 + i * 8192, R, C); const int Rb = Epi::PERM ? ((R & ~31) + perm32(R & 31)) : R;
        voffA[i] = (unsigned)(R * g.lda + C) * 2u; voffB[i] = (unsigned)(Rb * K + C) * 2u; }
    const size_t kstep = (size_t)(BK * 2);
    const size_t hstepA = (size_t)HALF * g.lda * 2, hstepB = (size_t)HALF * K * 2;
    const size_t tstepA = 2 * hstepA, tstepB = 2 * hstepB, cstepA = (size_t)g.acol * 2;
    const unsigned ldsw = (unsigned)wid * 1024u;
    const int aoff = lds_byte(wr * 64 + fr, fq * 8), boff = lds_byte(wc * 32 + fr, fq * 8);
#define PG8_SA(b, h) (((b) * 2 + (h)) * HTB)
#define PG8_SB(b, h) ((4 + (b) * 2 + (h)) * HTB)
#define PG8_STAGE(bufoff, gbase, voff) do { _Pragma("unroll") for (int _i = 0; _i < 2; ++_i) \
        __builtin_amdgcn_global_load_lds((const unsigned*)((const char*)(gbase) + (voff)[_i]), (PG8_LAS unsigned*)(lds + (bufoff) + ldsw + _i * 8192), 16, 0, 0); } while (0)
#define PG8_LDA(dst, b, h) do { _Pragma("unroll") for (int m = 0; m < 4; ++m) _Pragma("unroll") for (int k = 0; k < 2; ++k) dst[m][k] = *(const PG8_LAS bf16x8*)(lds + PG8_SA(b, h) + aoff + m * 2048 + k * 1024); } while (0)
#define PG8_LDB(dst, b, h) do { _Pragma("unroll") for (int n = 0; n < 2; ++n) _Pragma("unroll") for (int k = 0; k < 2; ++k) dst[n][k] = *(const PG8_LAS bf16x8*)(lds + PG8_SB(b, h) + boff + n * 2048 + k * 1024); } while (0)
#define PG8_MMA(ai, bj, At, Bt) do { __builtin_amdgcn_s_setprio(1); _Pragma("unroll") for (int m = 0; m < 4; ++m) _Pragma("unroll") for (int n = 0; n < 2; ++n) _Pragma("unroll") for (int k = 0; k < 2; ++k) \
        acc[ai][bj][m][n] = __builtin_amdgcn_mfma_f32_16x16x32_bf16(Bt[n][k], At[m][k], acc[ai][bj][m][n], 0, 0, 0); __builtin_amdgcn_s_setprio(0); } while (0)
#define PG8_WAIT_V(n) asm volatile("s_waitcnt vmcnt(" #n ")" ::: "memory")
#define PG8_WAIT_L(n) asm volatile("s_waitcnt lgkmcnt(" #n ")" ::: "memory")
#define PG8_BAR __builtin_amdgcn_s_barrier()
#define PG8_SCHED __builtin_amdgcn_sched_barrier(0)
    Unit cur, nxt; int ui = 0;
    if (!S.next(0, cur)) return;
    f32x4 acc[2][2][4][2];
#pragma unroll
    for (int a = 0; a < 2; ++a)
#pragma unroll
        for (int b = 0; b < 2; ++b)
#pragma unroll
            for (int m = 0; m < 4; ++m)
#pragma unroll
                for (int n = 0; n < 2; ++n) acc[a][b][m][n] = (f32x4){0.f, 0.f, 0.f, 0.f};
    bf16x8 At[4][2], B0[2][2], B1[2][2];
    const char* cA = (const char*)g.A + (size_t)cur.pm * tstepA + (size_t)cur.pn * cstepA; const char* cB = (const char*)g.Bt + (size_t)cur.pn * tstepB;
    S.a_ready(cur);
    PG8_STAGE(PG8_SB(0, 0), cB, voffB); PG8_STAGE(PG8_SA(0, 0), cA, voffA); PG8_STAGE(PG8_SB(0, 1), cB + hstepB, voffB); PG8_STAGE(PG8_SA(0, 1), cA + hstepA, voffA);
    if (wr == 1) PG8_BAR;
    PG8_WAIT_V(4); PG8_BAR;
    PG8_STAGE(PG8_SB(1, 0), cB + kstep, voffB); PG8_STAGE(PG8_SA(1, 0), cA + kstep, voffA); PG8_STAGE(PG8_SB(1, 1), cB + hstepB + kstep, voffB);
    PG8_WAIT_V(6); PG8_BAR;
    PG8_STAMP();
    for (;;) {
        const bool has_next = S.next(ui + 1, nxt);
        const char* nA = has_next ? (const char*)g.A + (size_t)nxt.pm * tstepA + (size_t)nxt.pn * cstepA : cA; const char* nB = has_next ? (const char*)g.Bt + (size_t)nxt.pn * tstepB : cB;
        for (int t = 0; t < nt; t += 2) {
            const bool last = (t == nt - 2);
            const char* a1 = cA + (size_t)(t + 1) * kstep;
            const char* a2 = last ? nA : cA + (size_t)(t + 2) * kstep; const char* b2 = last ? nB : cB + (size_t)(t + 2) * kstep;
            const char* a3 = a2 + kstep; const char* b3 = b2 + kstep;
            if (last && has_next) S.a_ready(nxt);
            PG8_LDB(B0, 0, 0); PG8_SCHED; PG8_LDA(At, 0, 0); PG8_STAGE(PG8_SA(1, 1), a1 + hstepA, voffA);
            PG8_WAIT_L(8); PG8_BAR; PG8_WAIT_L(0); PG8_MMA(0, 0, At, B0); PG8_BAR; PG8_SCHED;
            PG8_LDB(B1, 0, 1); PG8_STAGE(PG8_SB(0, 0), b2, voffB);
            PG8_BAR; PG8_WAIT_L(0); PG8_MMA(0, 1, At, B1); PG8_BAR;
            PG8_LDA(At, 0, 1); PG8_STAGE(PG8_SA(0, 0), a2, voffA);
            PG8_BAR; PG8_WAIT_L(0); PG8_MMA(1, 0, At, B0); PG8_BAR; PG8_SCHED;
            PG8_STAGE(PG8_SB(0, 1), b2 + hstepB, voffB);
            PG8_WAIT_V(6); PG8_BAR; PG8_MMA(1, 1, At, B1); PG8_BAR;
            PG8_LDB(B0, 1, 0); PG8_SCHED; PG8_LDA(At, 1, 0); PG8_STAGE(PG8_SA(0, 1), a2 + hstepA, voffA);
            PG8_WAIT_L(8); PG8_BAR; PG8_WAIT_L(0); PG8_MMA(0, 0, At, B0); PG8_BAR; PG8_SCHED;
            PG8_LDB(B1, 1, 1); PG8_STAGE(PG8_SB(1, 0), b3, voffB);
            PG8_BAR; PG8_WAIT_L(0); PG8_MMA(0, 1, At, B1); PG8_BAR;
            PG8_LDA(At, 1, 1); PG8_STAGE(PG8_SA(1, 0), a3, voffA);
            PG8_BAR; PG8_WAIT_L(0); PG8_MMA(1, 0, At, B0); PG8_BAR; PG8_SCHED;
            PG8_STAGE(PG8_SB(1, 1), b3 + hstepB, voffB);
            PG8_WAIT_V(6); PG8_BAR; PG8_MMA(1, 1, At, B1); PG8_BAR;
        }
        PG8_STAMP();
        if constexpr (!Epi::AFTER_DRAIN) { E(acc, cur, wr, wc, fr, fq); S.done(cur); }
        PG8_STAMP();
        if (!has_next) break;
#pragma unroll
        for (int a = 0; a < 2; ++a)
#pragma unroll
            for (int b = 0; b < 2; ++b)
#pragma unroll
                for (int m = 0; m < 4; ++m)
#pragma unroll
                    for (int n = 0; n < 2; ++n) acc[a][b][m][n] = (f32x4){0.f, 0.f, 0.f, 0.f};
        cur = nxt; cA = nA; cB = nB; ++ui;
    }
    PG8_WAIT_V(0);
    if (wr == 0) PG8_BAR;
    PG8_BAR;
    if constexpr (Epi::AFTER_DRAIN) { E.fused(acc, cur, wr, wc, fr, fq, lds, wid, lane); S.done(cur); }
    PG8_STAMP();
#undef PG8_STAMP
#undef PG8_SA
#undef PG8_SB
#undef PG8_STAGE
#undef PG8_LDA
#undef PG8_LDB
#undef PG8_MMA
#undef PG8_WAIT_V
#undef PG8_WAIT_L
#undef PG8_BAR
#undef PG8_SCHED
}
}


using pg8::bf16_t; using pg8::bf16x8; using pg8::f32x4; using pg8::u32x4;
typedef unsigned u32x2 __attribute__((ext_vector_type(2)));
#define LAS __attribute__((address_space(3)))

constexpr int D = 1024, MP = 65536, MSAMP = 512, MT = MP + MSAMP, DFF = 4096;
constexpr int LDS_BYTES = 147456;
constexpr float EPS = 1e-6f;
constexpr size_t WS_WIN = 0, WS_WOUT = WS_WIN + 16777216, WS_WUP = WS_WOUT + 8388608, WS_WDOWN = WS_WUP + 33554432, WS_WPOOL = WS_WDOWN + 33554432,
                 WS_MOD = WS_WPOOL + 1048576, WS_VSS = WS_MOD + 2359296, WS_H = WS_VSS + 8454144, WS_MIX = WS_H + 135266304, WS_Z = WS_MIX + 135266304, WS_END = WS_Z + 541065216;
constexpr size_t OUT_YS = 67108864, OUT_SPP = 67633152, OUT_SSS = 67878912, OUT_SPS = 69976064;

struct Params { const float* in[17]; float* out; unsigned char* ws; };

__device__ __forceinline__ float bf_lo(unsigned w) { return __uint_as_float(w << 16); }
__device__ __forceinline__ float bf_hi(unsigned w) { return __uint_as_float(w & 0xffff0000u); }
__device__ __forceinline__ void unpack8(const u32x4 w, float (&f)[8]) {
    f[0] = bf_lo(w.x); f[1] = bf_hi(w.x); f[2] = bf_lo(w.y); f[3] = bf_hi(w.y); f[4] = bf_lo(w.z); f[5] = bf_hi(w.z); f[6] = bf_lo(w.w); f[7] = bf_hi(w.w); }
__device__ __forceinline__ u32x4 pack8(const float (&f)[8]) {
    u32x4 w; w.x = pg8::cvt_pk_bf16(f[0], f[1]); w.y = pg8::cvt_pk_bf16(f[2], f[3]); w.z = pg8::cvt_pk_bf16(f[4], f[5]); w.w = pg8::cvt_pk_bf16(f[6], f[7]); return w; }
__device__ __forceinline__ int opaque_tid() { int t = threadIdx.x; asm volatile("" : "+v"(t)); return t; }
__device__ __forceinline__ float wave_sum(float v) {
#pragma unroll
    for (int o = 32; o >= 1; o >>= 1) v += __shfl_xor(v, o);
    return v; }
__device__ __forceinline__ float gelu_tanh(float x) {
    const float y = x * (1.5957691216f + 0.0713548163f * x * x);
    const float e = __builtin_amdgcn_exp2f(-1.4426950409f * y);
    return x * __builtin_amdgcn_rcpf(1.0f + e); }

template <int ACT> struct EpiAct {
    static constexpr bool PERM = true, AFTER_DRAIN = false;
    bf16_t* O; int ldc; float* vss; const float* scale;
    __device__ __forceinline__ void operator()(const f32x4 (&acc)[2][2][4][2], const pg8::Unit& u, int wr, int wc, int fr, int fq) const {
        const int row0 = u.pm * 256 + wr * 64 + fr, col0 = u.pn * 256 + wc * 32 + 8 * fq;
        f32x4 sv[2][2];
#pragma unroll
        for (int bj = 0; bj < 2; ++bj)
#pragma unroll
            for (int n = 0; n < 2; ++n) sv[bj][n] = (ACT == 2 && scale) ? *(const f32x4*)(scale + col0 + bj * 128 + 4 * n) : (f32x4){1.f, 1.f, 1.f, 1.f};
#pragma unroll
        for (int ai = 0; ai < 2; ++ai)
#pragma unroll
            for (int m = 0; m < 4; ++m) {
                const int row = row0 + ai * 128 + m * 16;
                bf16_t* rowp = O + (size_t)row * ldc + col0;
                float ss = 0.f;
#pragma unroll
                for (int bj = 0; bj < 2; ++bj) {
                    f32x4 v0 = acc[ai][bj][m][0], v1 = acc[ai][bj][m][1];
                    if (ACT == 0) {
#pragma unroll
                        for (int j = 0; j < 4; ++j) { v0[j] = gelu_tanh(v0[j]); v1[j] = gelu_tanh(v1[j]); ss += v0[j] * v0[j] + v1[j] * v1[j]; }
                    }
                    if (ACT == 1) {
#pragma unroll
                        for (int j = 0; j < 4; ++j) { const float a = fmaxf(v0[j], 0.f), b = fmaxf(v1[j], 0.f); v0[j] = a * a; v1[j] = b * b; }
                    }
                    if (ACT == 2) { v0 *= sv[bj][0]; v1 *= sv[bj][1]; }
                    u32x4 w; w.x = pg8::cvt_pk_bf16(v0[0], v0[1]); w.y = pg8::cvt_pk_bf16(v0[2], v0[3]); w.z = pg8::cvt_pk_bf16(v1[0], v1[1]); w.w = pg8::cvt_pk_bf16(v1[2], v1[3]);
                    *(u32x4*)(rowp + bj * 128) = w;
                }
                if (ACT == 0) {
                    if (u.pn >= 8) { ss += __shfl_xor(ss, 16); ss += __shfl_xor(ss, 32); if (fq == 0) vss[(size_t)row * 32 + (u.pn - 8) * 4 + wc] = ss; }
                }
            }
    }
};

__device__ __forceinline__ void mod_phase(const Params& P, LAS float* lds) {
    LAS float* sc = lds; LAS float* red = lds + 24576;
    const int tid = opaque_tid(), lane = tid & 63, wv = tid >> 6;
    for (int i = tid; i < 24576; i += 512) { const int b = i >> 10, k = i & 1023; const float c = b < 8 ? P.in[3][b * 1024 + k] : P.in[4][(b - 8) * 1024 + k]; sc[k * 24 + b] = c / (1.0f + __expf(-c)); }
    __syncthreads();
    float* modo = (float*)(P.ws + WS_MOD);
    for (int task = blockIdx.x; task < 384; task += gridDim.x) {
        const int l = task / 96, n0 = (task % 96) * 64;
        const float* w = P.in[6] + (size_t)l * 1024 * 6144 + n0 + lane;
        float acc[24];
#pragma unroll
        for (int b = 0; b < 24; ++b) acc[b] = 0.f;
        const int k0 = wv * 128;
#pragma unroll 4
        for (int k = k0; k < k0 + 128; ++k) {
            const float wk = w[(size_t)k * 6144];
            const LAS f32x4* s4 = (const LAS f32x4*)(sc + k * 24);
#pragma unroll
            for (int q = 0; q < 6; ++q) { const f32x4 s = s4[q]; acc[4 * q + 0] += wk * s[0]; acc[4 * q + 1] += wk * s[1]; acc[4 * q + 2] += wk * s[2]; acc[4 * q + 3] += wk * s[3]; }
        }
#pragma unroll
        for (int b = 0; b < 24; ++b) red[(wv * 24 + b) * 64 + lane] = acc[b];
        __syncthreads();
        for (int o = tid; o < 1536; o += 512) {
            const int b = o >> 6, n = o & 63; float s = 0.f;
#pragma unroll
            for (int w8 = 0; w8 < 8; ++w8) s += red[(w8 * 24 + b) * 64 + n];
            modo[(size_t)(l * 24 + b) * 6144 + n0 + n] = s + P.in[7][l * 6144 + n0 + n];
        }
        __syncthreads();
    }
}

__device__ __forceinline__ void transpose_tile(const float* src, bf16_t* dst, int K, int N, int k0, int n0, LAS float* tile) {
    const int tid = opaque_tid();
#pragma unroll
    for (int it = 0; it < 2; ++it) {
        const int idx = tid + 512 * it, kr = idx >> 4, c4 = (idx & 15) * 4;
        const f32x4 v = *(const f32x4*)(src + (size_t)(k0 + kr) * N + n0 + c4);
        tile[kr * 65 + c4 + 0] = v[0]; tile[kr * 65 + c4 + 1] = v[1]; tile[kr * 65 + c4 + 2] = v[2]; tile[kr * 65 + c4 + 3] = v[3];
    }
    __syncthreads();
    {
        const int n = tid >> 3, kc = tid & 7; float f[8];
#pragma unroll
        for (int e = 0; e < 8; ++e) f[e] = tile[(8 * kc + e) * 65 + n];
        *(u32x4*)(dst + (size_t)(n0 + n) * K + k0 + 8 * kc) = pack8(f);
    }
    __syncthreads();
}
__device__ __forceinline__ void convert_phase(const Params& P, LAS float* tile) {
    for (int t = blockIdx.x; t < 11392; t += gridDim.x) {
        const float* src; bf16_t* dst; int K, N, loc;
        if (t < 2048)       { src = P.in[8];  dst = (bf16_t*)(P.ws + WS_WIN);   K = 1024; N = 4096; loc = t; }
        else if (t < 3072)  { src = P.in[12]; dst = (bf16_t*)(P.ws + WS_WOUT);  K = 2048; N = 1024; loc = t - 2048; }
        else if (t < 7168)  { src = P.in[15]; dst = (bf16_t*)(P.ws + WS_WUP);   K = 1024; N = 4096; loc = t - 3072; }
        else if (t < 11264) { src = P.in[16]; dst = (bf16_t*)(P.ws + WS_WDOWN); K = 4096; N = 1024; loc = t - 7168; }
        else                { src = P.in[13]; dst = (bf16_t*)(P.ws + WS_WPOOL); K = 256;  N = 256;  loc = t - 11264; }
        const int tn = N >> 6, per = (K >> 6) * tn, mat = loc / per, rem = loc - mat * per, kt = rem / tn, ntile = rem - kt * tn;
        transpose_tile(src + (size_t)mat * K * N, dst + (size_t)mat * K * N, K, N, kt * 64, ntile * 64, tile);
    }
}

__device__ __forceinline__ void resnorm_phase(const Params& P, int li, int mode) {
    const int tid = opaque_tid(), lane = tid & 63, wv = tid >> 6;
    const float* modb = (const float*)(P.ws + WS_MOD);
    const bf16_t* mix = (const bf16_t*)(P.ws + WS_MIX);
    bf16_t* hbuf = (bf16_t*)(P.ws + WS_H);
    const float* gn = P.in[5];
    const bool has_mix = mode != 0, has_h = !(mode == 2 && li == 3), from_in = (mode == 0) || (mode == 1 && li == 0);
    const int ln = mode == 2 ? li + 1 : li;
    const int g_res_idx = li * 4 + (mode == 1 ? 1 : 3), gate_chunk = mode == 1 ? 2 : 5;
    const int g2_idx = ln * 4 + (mode == 1 ? 2 : 0), sc_chunk = mode == 1 ? 4 : 1, sh_chunk = mode == 1 ? 3 : 0;
    const bool wstate = has_h && mode != 1 && (ln & 1);
    const int jl = ln >> 1;
    for (int t = blockIdx.x * 8 + wv; t < 2064; t += gridDim.x * 8) {
        const int row0 = t * 32, b = t < 2048 ? (t >> 8) : 8 + (t - 2048);
        f32x4 cg4[4], ca4[4], cs4[4];
#pragma unroll
        for (int q = 0; q < 4; ++q) {
            const int col = (q >> 1) * 512 + 8 * lane + (q & 1) * 4;
            cg4[q] = (f32x4){0.f, 0.f, 0.f, 0.f}; ca4[q] = cg4[q]; cs4[q] = cg4[q];
            if (has_mix) cg4[q] = *(const f32x4*)(modb + ((size_t)(li * 24 + b) * 6 + gate_chunk) * 1024 + col) * *(const f32x4*)(gn + g_res_idx * 1024 + col);
            if (has_h) {
                ca4[q] = *(const f32x4*)(gn + g2_idx * 1024 + col) * (*(const f32x4*)(modb + ((size_t)(ln * 24 + b) * 6 + sc_chunk) * 1024 + col) + 1.0f);
                cs4[q] = *(const f32x4*)(modb + ((size_t)(ln * 24 + b) * 6 + sh_chunk) * 1024 + col);
            }
        }
#pragma unroll 2
        for (int r = 0; r < 32; ++r) {
            const int row = row0 + r;
            const float* xs = from_in ? (row < MP ? P.in[0] + (size_t)row * 1024 : P.in[1] + (size_t)(row - MP) * 1024) : P.out + (size_t)row * 1024;
            f32x4 x4[4];
#pragma unroll
            for (int q = 0; q < 4; ++q) x4[q] = *(const f32x4*)(xs + (q >> 1) * 512 + 8 * lane + (q & 1) * 4);
            if (has_mix) {
                u32x4 mw[2];
#pragma unroll
                for (int hh = 0; hh < 2; ++hh) mw[hh] = *(const u32x4*)(mix + (size_t)row * 1024 + hh * 512 + 8 * lane);
                f32x4 m4[4]; float ss = 0.f;
#pragma unroll
                for (int hh = 0; hh < 2; ++hh) { float f[8]; unpack8(mw[hh], f); m4[2 * hh] = (f32x4){f[0], f[1], f[2], f[3]}; m4[2 * hh + 1] = (f32x4){f[4], f[5], f[6], f[7]}; }
#pragma unroll
                for (int q = 0; q < 4; ++q) ss += m4[q][0] * m4[q][0] + m4[q][1] * m4[q][1] + m4[q][2] * m4[q][2] + m4[q][3] * m4[q][3];
                ss = wave_sum(ss);
                const float r1 = rsqrtf(ss * (1.0f / 1024.0f) + EPS);
#pragma unroll
                for (int q = 0; q < 4; ++q) x4[q] += m4[q] * r1 * cg4[q];
            }
            if (mode != 0) {
#pragma unroll
                for (int q = 0; q < 4; ++q) *(f32x4*)(P.out + (size_t)row * 1024 + (q >> 1) * 512 + 8 * lane + (q & 1) * 4) = x4[q];
            }
            if (has_h) {
                float ss = 0.f;
#pragma unroll
                for (int q = 0; q < 4; ++q) ss += x4[q][0] * x4[q][0] + x4[q][1] * x4[q][1] + x4[q][2] * x4[q][2] + x4[q][3] * x4[q][3];
                ss = wave_sum(ss);
                const float r2 = rsqrtf(ss * (1.0f / 1024.0f) + EPS);
                f32x4 h4[4];
#pragma unroll
                for (int q = 0; q < 4; ++q) h4[q] = x4[q] * r2 * ca4[q] + cs4[q];
#pragma unroll
                for (int hh = 0; hh < 2; ++hh) {
                    u32x4 w; w.x = pg8::cvt_pk_bf16(h4[2 * hh][0], h4[2 * hh][1]); w.y = pg8::cvt_pk_bf16(h4[2 * hh][2], h4[2 * hh][3]);
                    w.z = pg8::cvt_pk_bf16(h4[2 * hh + 1][0], h4[2 * hh + 1][1]); w.w = pg8::cvt_pk_bf16(h4[2 * hh + 1][2], h4[2 * hh + 1][3]);
                    *(u32x4*)(hbuf + (size_t)row * 1024 + hh * 512 + 8 * lane) = w;
                }
                if (wstate) {
                    float* dst = nullptr;
                    if (row < MP) { const int rr = row & 8191; if (rr >= 8177) dst = P.out + OUT_SPP + ((size_t)(jl * 8 + b) * 15 + (rr - 8177)) * 1024; }
                    else { const int rr = (row - MP) & 31; if (rr >= 17) dst = P.out + OUT_SPS + ((size_t)(jl * 16 + (b - 8)) * 15 + (rr - 17)) * 1024; }
                    if (dst) {
#pragma unroll
                        for (int q = 0; q < 4; ++q) *(f32x4*)(dst + (q >> 1) * 512 + 8 * lane + (q & 1) * 4) = h4[q];
                    }
                }
            }
        }
    }
}

__device__ __forceinline__ void pool_phase(const Params& P, int jl) {
    const int tid = opaque_tid(), lane = tid & 63, wv = tid >> 6;
    const bf16_t* h = (const bf16_t*)(P.ws + WS_H); bf16_t* pooled = (bf16_t*)(P.ws + WS_Z);
    for (int task = blockIdx.x * 8 + wv; task < 2080; task += gridDim.x * 8) {
        const bool samp = task >= 2048; const int tt = samp ? task - 2048 : task, half = tt & 1;
        const int row0 = samp ? MP + (tt >> 1) * 32 : (tt >> 1) * 64, nrows = samp ? 32 : 64, pos0 = samp ? 0 : (row0 & 8191);
        const int col = half * 512 + lane * 8, w = 2 << (col >> 8);
        const float* cache = P.in[2] + (size_t)((jl * 16 + (samp ? (tt >> 1) : 0)) * 15) * 1024 + col;
        const bf16_t* hp = h + (size_t)row0 * 1024 + col;
        float s[8];
#pragma unroll
        for (int e = 0; e < 8; ++e) s[e] = 0.f;
        for (int k = 1; k < 16; ++k) {
            if (k < w) {
                const int p = pos0 - k;
                if (p >= 0) { float f[8]; unpack8(*(const u32x4*)(hp - (size_t)k * 1024), f);
#pragma unroll
                    for (int e = 0; e < 8; ++e) s[e] += f[e]; }
                else if (samp) { const f32x4 a = *(const f32x4*)(cache + (15 + p) * 1024), c = *(const f32x4*)(cache + (15 + p) * 1024 + 4);
                    s[0] += a[0]; s[1] += a[1]; s[2] += a[2]; s[3] += a[3]; s[4] += c[0]; s[5] += c[1]; s[6] += c[2]; s[7] += c[3]; }
            }
        }
        const float inv_w = 1.0f / (float)w;
        for (int r = 0; r < nrows; ++r) {
            float c[8]; unpack8(*(const u32x4*)(hp + (size_t)r * 1024), c);
            const int p = pos0 + r;
            const float inv = (samp || p + 1 >= w) ? inv_w : 1.0f / (float)(p + 1);
            float o[8];
#pragma unroll
            for (int e = 0; e < 8; ++e) { s[e] += c[e]; o[e] = s[e] * inv - c[e]; }
            *(u32x4*)(pooled + (size_t)(row0 + r) * 1024 + col) = pack8(o);
            const int po = p - w + 1;
            if (po >= 0) { float f[8]; unpack8(*(const u32x4*)(hp + (ptrdiff_t)(r - w + 1) * 1024), f);
#pragma unroll
                for (int e = 0; e < 8; ++e) s[e] -= f[e]; }
            else if (samp) { const f32x4 a = *(const f32x4*)(cache + (15 + po) * 1024), cc = *(const f32x4*)(cache + (15 + po) * 1024 + 4);
                s[0] -= a[0]; s[1] -= a[1]; s[2] -= a[2]; s[3] -= a[3]; s[4] -= cc[0]; s[5] -= cc[1]; s[6] -= cc[2]; s[7] -= cc[3]; }
        }
    }
}

__device__ __forceinline__ unsigned off_b(unsigned row, unsigned ch) { return 256u * row + 16u * (ch ^ (((row & 3) << 2) | ((row >> 2) & 3))); }
__device__ __forceinline__ unsigned tr_addr16(unsigned lane, unsigned c, unsigned ks, unsigned t) {
    const unsigned g = lane >> 4, q = (lane & 15) >> 2, p = lane & 3;
    return off_b(32 * ks + 8 * g + 4 * t + q, 2 * c + (p >> 1)) + 8 * (p & 1);
}
__device__ __forceinline__ bf16x8 tr_read_pair(unsigned a0, unsigned a1) {
    u32x2 lo, hi;
    asm volatile("ds_read_b64_tr_b16 %0, %2\n\tds_read_b64_tr_b16 %1, %3\n\ts_waitcnt lgkmcnt(0)" : "=&v"(lo), "=&v"(hi) : "v"(a0), "v"(a1) : "memory");
    u32x4 w; w.x = lo.x; w.y = lo.y; w.z = hi.x; w.w = hi.y;
    return __builtin_bit_cast(bf16x8, w);
}

template <bool SAMP>
__device__ __forceinline__ void gate_unit(const bf16x8 (&wf)[8][4], const float (&bsl)[8], bf16_t* z, int r0, int g, unsigned img, int lane, int wv) {
    constexpr int NIH = SAMP ? 1 : 2, NI = SAMP ? 2 : 4, NKS = SAMP ? 1 : 4;
    const int fr = lane & 15, fq = lane >> 4, half = wv >> 2;
#pragma unroll
    for (int n = 0; n < 2; ++n) {
        const unsigned c = 2 * (wv & 3) + n;
        bf16x8 vf[NKS];
#pragma unroll
        for (int ks = 0; ks < NKS; ++ks) vf[ks] = tr_read_pair(img + half * 32768 + tr_addr16(lane, c, ks, 0), img + half * 32768 + tr_addr16(lane, c, ks, 1));
#pragma unroll
        for (int ih = 0; ih < NIH; ++ih) {
            f32x4 acc[NI];
#pragma unroll
            for (int ii = 0; ii < NI; ++ii) acc[ii] = (f32x4){0.f, 0.f, 0.f, 0.f};
#pragma unroll
            for (int ii = 0; ii < NI; ++ii)
#pragma unroll
                for (int ks = 0; ks < NKS; ++ks)
                    if (SAMP || ks < 2 || ih == 1) acc[ii] = __builtin_amdgcn_mfma_f32_16x16x32_bf16(vf[ks], wf[ih * 4 + ii][ks], acc[ii], 0, 0, 0);
#pragma unroll
            for (int ii = 0; ii < NI; ++ii) {
                const int it = ih * 4 + ii, i = 16 * it + fr;
                bf16_t* ptr = z + (size_t)(r0 + i) * 4096 + g * 256 + half * 128 + 16 * c + 4 * fq;
                const u32x2 uw = *(const u32x2*)ptr;
                const f32x4 a = acc[ii] + bsl[it];
                u32x2 ow; ow.x = pg8::cvt_pk_bf16(bf_lo(uw.x) * a[0], bf_hi(uw.x) * a[1]); ow.y = pg8::cvt_pk_bf16(bf_lo(uw.y) * a[2], bf_hi(uw.y) * a[3]);
                *(u32x2*)ptr = ow;
            }
        }
    }
}

__device__ __forceinline__ void gate_phase(const Params& P, int jl, LAS unsigned char* lds) {
    const int tid = opaque_tid(), lane = tid & 63, wv = tid >> 6, fr = lane & 15, fq = lane >> 4;
    const int g = blockIdx.x & 7, cstride = gridDim.x >> 3;
    bf16_t* z = (bf16_t*)(P.ws + WS_Z);
    const float* vss = (const float*)(P.ws + WS_VSS);
    LAS float* rstd_l = (LAS float*)(lds + 65536);
    const unsigned img = (unsigned)(size_t)lds;
    bf16x8 wf[8][4];
    const float* wsg = P.in[10] + (size_t)(jl * 8 + g) * 128 * 128;
#pragma unroll
    for (int it = 0; it < 8; ++it)
#pragma unroll
        for (int ks = 0; ks < 4; ++ks) {
            if (ks < 2 || it >= 4) {
                const float* p = wsg + (16 * it + fr) * 128 + 32 * ks + 8 * fq;
                const f32x4 a = *(const f32x4*)p, b = *(const f32x4*)(p + 4);
                u32x4 w; w.x = pg8::cvt_pk_bf16(a[0], a[1]); w.y = pg8::cvt_pk_bf16(a[2], a[3]); w.z = pg8::cvt_pk_bf16(b[0], b[1]); w.w = pg8::cvt_pk_bf16(b[2], b[3]);
                wf[it][ks] = __builtin_bit_cast(bf16x8, w);
            } else wf[it][ks] = (bf16x8){0, 0, 0, 0, 0, 0, 0, 0};
        }
    float bsl[8];
#pragma unroll
    for (int it = 0; it < 8; ++it) bsl[it] = P.in[11][(jl * 8 + g) * 128 + 16 * it + fr];
    const int piece = tid & 31;
    float gv[8];
    { const f32x4 a = *(const f32x4*)(P.in[9] + jl * 2048 + g * 256 + piece * 8), b = *(const f32x4*)(P.in[9] + jl * 2048 + g * 256 + piece * 8 + 4);
      gv[0] = a[0]; gv[1] = a[1]; gv[2] = a[2]; gv[3] = a[3]; gv[4] = b[0]; gv[5] = b[1]; gv[6] = b[2]; gv[7] = b[3]; }
    for (int ch = blockIdx.x >> 3; ch < 528; ch += cstride) {
        const bool samp = ch >= 512; const int T = samp ? 32 : 128, r0 = samp ? MP + (ch - 512) * 32 : ch * 128;
        if (tid < T) {
            const f32x4* pv = (const f32x4*)(vss + (size_t)(r0 + tid) * 32); float s = 0.f;
#pragma unroll
            for (int q = 0; q < 8; ++q) { const f32x4 v = pv[q]; s += (v[0] + v[1]) + (v[2] + v[3]); }
            rstd_l[tid] = rsqrtf(s * (1.0f / 2048.0f) + EPS);
        }
        __syncthreads();
        for (int idx = tid; idx < T * 32; idx += 512) {
            const int j = idx >> 5;
            float f[8]; unpack8(*(const u32x4*)(z + (size_t)(r0 + j) * 4096 + 2048 + g * 256 + piece * 8), f);
            const float rs = rstd_l[j];
#pragma unroll
            for (int e = 0; e < 8; ++e) f[e] = f[e] * rs * gv[e];
            if (samp) {
                float* dst = P.out + OUT_SSS + ((size_t)(jl * 16 + (ch - 512)) * 32 + j) * 2048 + g * 256 + piece * 8;
                *(f32x4*)dst = (f32x4){f[0], f[1], f[2], f[3]}; *(f32x4*)(dst + 4) = (f32x4){f[4], f[5], f[6], f[7]};
            }
            *(LAS u32x4*)(lds + (piece >> 4) * 32768 + off_b((unsigned)j, (unsigned)(piece & 15))) = pack8(f);
        }
        __syncthreads();
        if (samp) gate_unit<true>(wf, bsl, z, r0, g, img, lane, wv);
        else gate_unit<false>(wf, bsl, z, r0, g, img, lane, wv);
        __syncthreads();
    }
}

__global__ void __launch_bounds__(512, 2) mega(Params P) {
    extern __shared__ __attribute__((aligned(16))) unsigned char lds_raw[];
    cg::grid_group grid = cg::this_grid();
    LAS unsigned char* lds = (LAS unsigned char*)lds_raw;
    bf16_t* hbuf = (bf16_t*)(P.ws + WS_H); bf16_t* zbuf = (bf16_t*)(P.ws + WS_Z); bf16_t* mixbuf = (bf16_t*)(P.ws + WS_MIX);
    const int G = gridDim.x, bid = blockIdx.x;

    mod_phase(P, (LAS float*)lds);
    convert_phase(P, (LAS float*)lds);
    grid.sync();
    resnorm_phase(P, 0, 0);
    grid.sync();
#pragma unroll 1
    for (int li = 0; li < 4; ++li) {
        const int jl = li >> 1;
        pg8::Gemm gm; const float* scale = nullptr;
        if ((li & 1) == 0) {
            {
                pg8::Gemm g{hbuf, (const bf16_t*)(P.ws + WS_WIN) + (size_t)jl * 4096 * 1024, MT, 4096, 1024, 1024, 0};
                pg8::StaticOrder S; S.init(MT, 4096, G, bid);
                EpiAct<0> E{zbuf, 4096, (float*)(P.ws + WS_VSS), nullptr};
                pg8::gemm_phase<EpiAct<0>, pg8::StaticOrder>(lds, g, S, E);
            }
            grid.sync();
            gate_phase(P, jl, lds);
            grid.sync();
            gm = pg8::Gemm{zbuf, (const bf16_t*)(P.ws + WS_WOUT) + (size_t)jl * 1024 * 2048, MT, 1024, 2048, 4096, 0};
        } else {
            pool_phase(P, jl);
            grid.sync();
            gm = pg8::Gemm{zbuf, (const bf16_t*)(P.ws + WS_WPOOL) + (size_t)jl * 1024 * 256, MT, 1024, 256, 1024, 256};
            scale = P.in[14] + jl * 1024;
        }
#pragma unroll 1
        for (int pass = 0; pass < 2; ++pass) {
            {
                pg8::StaticOrder S; S.init(MT, 1024, G, bid);
                EpiAct<2> E{mixbuf, 1024, nullptr, scale};
                pg8::gemm_phase<EpiAct<2>, pg8::StaticOrder>(lds, gm, S, E);
            }
            grid.sync();
            resnorm_phase(P, li, pass + 1);
            grid.sync();
            if (pass == 0) {
                {
                    pg8::Gemm g{hbuf, (const bf16_t*)(P.ws + WS_WUP) + (size_t)li * 4096 * 1024, MT, 4096, 1024, 1024, 0};
                    pg8::StaticOrder S; S.init(MT, 4096, G, bid);
                    EpiAct<1> E{zbuf, 4096, nullptr, nullptr};
                    pg8::gemm_phase<EpiAct<1>, pg8::StaticOrder>(lds, g, S, E);
                }
                grid.sync();
                gm = pg8::Gemm{zbuf, (const bf16_t*)(P.ws + WS_WDOWN) + (size_t)li * 1024 * 4096, MT, 1024, 4096, 4096, 0};
                scale = nullptr;
            }
        }
    }
}

extern "C" void kernel_launch(void* const* d_in, const int* in_sizes, int n_in, void* d_out, int out_size, void* d_ws, size_t ws_size, hipStream_t stream) {
    static int grid = 0;
    if (grid == 0) {
        if (n_in != 17 || ws_size < WS_END) { fprintf(stderr, "kernel_launch: unexpected n_in %d / ws_size %zu (need %zu)\n", n_in, ws_size, (size_t)WS_END); grid = -1; return; }
        int dev = 0, cus = 0, per_cu = 0;
        hipGetDevice(&dev);
        hipDeviceGetAttribute(&cus, hipDeviceAttributeMultiprocessorCount, dev);
        if (hipFuncSetAttribute((const void*)mega, hipFuncAttributeMaxDynamicSharedMemorySize, LDS_BYTES) != hipSuccess) { fprintf(stderr, "kernel_launch: hipFuncSetAttribute failed\n"); grid = -1; return; }
        if (hipOccupancyMaxActiveBlocksPerMultiprocessor(&per_cu, (const void*)mega, 512, LDS_BYTES) != hipSuccess || per_cu < 1) { fprintf(stderr, "kernel_launch: occupancy query gave %d\n", per_cu); per_cu = 1; (void)hipGetLastError(); }
        grid = (cus * per_cu) & ~7;
        if (grid < 8) { grid = -1; return; }
    }
    if (grid < 0) return;
    Params p{};
    for (int i = 0; i < 17; ++i) p.in[i] = (const float*)d_in[i];
    p.out = (float*)d_out; p.ws = (unsigned char*)d_ws;
    void* args[] = {&p};
    hipError_t e = hipLaunchCooperativeKernel((const void*)mega, dim3(grid), dim3(512), args, LDS_BYTES, stream);
    if (e != hipSuccess) fprintf(stderr, "cooperative launch failed: %s (grid %d)\n", hipGetErrorString(e), grid);
}
```

```cpp
#include <hip/hip_runtime.h>
#include <hip/hip_cooperative_groups.h>
#include <cstdio>
namespace cg = cooperative_groups;

namespace pg8 {
#define PG8_LAS __attribute__((address_space(3)))
typedef unsigned short bf16_t;
typedef short bf16x8 __attribute__((ext_vector_type(8)));
typedef float f32x4 __attribute__((ext_vector_type(4)));
typedef unsigned u32x4 __attribute__((ext_vector_type(4)));
constexpr int BM = 256, BK = 64, HALF = 128, HTB = HALF * BK * 2  , STAGE_BYTES = 8 * HTB, NXCD = 8, WGM = 8;

__host__ __device__ __forceinline__ int lds_byte(int r, int c) { const int st = (r >> 4) * 2 + (c >> 5), rr = r & 15, cc = c & 31, ob = rr * 64 + cc * 2; return st * 1024 + (ob ^ (((ob >> 9) & 1) << 5)); }
__host__ __device__ __forceinline__ void stage_rc(int b, int& R, int& C) { const int st = b / 1024, sb = b % 1024, swz = sb ^ (((sb >> 9) & 1) << 5); R = (st >> 1) * 16 + swz / 64; C = (st & 1) * 32 + (swz % 64) / 2; }
__host__ __device__ __forceinline__ int perm32(int rho) { const int n = rho >> 4, i = rho & 15; return 8 * (i >> 2) + 4 * n + (i & 3); }

struct Unit { int pm, pn; };
struct Gemm { const bf16_t* A; const bf16_t* Bt; int M, N, K, lda, acol; };

struct StaticOrder {
    int nM, nN, nwg, G, c;
    __host__ __device__ void init(int M, int N, int G_, int c_) { nM = M / BM; nN = N / BM; nwg = nM * nN; G = G_; c = c_; }
    __host__ __device__ bool next(int i, Unit& u) const {
        const long L = (long)i * G + c; if (L >= nwg) return false;
        int wgid = (int)L; { const int q = nwg / NXCD, r = nwg % NXCD, xcd = wgid % NXCD, off = wgid / NXCD; wgid = (xcd < r ? xcd * (q + 1) : r * (q + 1) + (xcd - r) * q) + off; }
        const int nig = WGM * nN, gid = wgid / nig, fm = gid * WGM, gsz = (nM - fm) < WGM ? (nM - fm) : WGM;
        u.pm = fm + ((wgid % nig) % gsz); u.pn = (wgid % nig) / gsz; return true;
    }
    __device__ __forceinline__ void a_ready(const Unit&) const {}
    __device__ __forceinline__ void done(const Unit&) const {}
};

__device__ __forceinline__ unsigned cvt_pk_bf16(float lo, float hi) { unsigned r; asm("v_cvt_pk_bf16_f32 %0, %1, %2" : "=v"(r) : "v"(lo), "v"(hi)); return r; }
template <class Epi, class Sched>
__device__ __forceinline__ void gemm_phase(PG8_LAS unsigned char* lds, const Gemm g, const Sched& S, const Epi& E) {
    int tid_ = threadIdx.x; asm volatile("" : "+v"(tid_));
    const int tid = tid_, wid = __builtin_amdgcn_readfirstlane(tid >> 6), lane = tid & 63, wr = wid >> 2, wc = wid & 3, fr = lane & 15, fq = lane >> 4;
    const int K = g.K, nt = K / BK;
#define PG8_STAMP() do { } while (0)
    PG8_STAMP();
    unsigned voffA[2], voffB[2];
#pragma unroll
    for (int i = 0; i < 2; ++i) { int R, C; stage_rc(tid * 16 + i * 8192, R, C); const int Rb = Epi::PERM ? ((R & ~31) + perm32(R & 31)) : R;
        voffA[i] = (unsigned)(R * g.lda + C) * 2u; voffB[i] = (unsigned)(Rb * K + C) * 2u; }
    const size_t kstep = (size_t)(BK * 2);
    const size_t hstepA = (size_t)HALF * g.lda * 2, hstepB = (size_t)HALF * K * 2;
    const size_t tstepA = 2 * hstepA, tstepB = 2 * hstepB, cstepA = (size_t)g.acol * 2;
    const unsigned ldsw = (unsigned)wid * 1024u;
    const int aoff = lds_byte(wr * 64 + fr, fq * 8), boff = lds_byte(wc * 32 + fr, fq * 8);
#define PG8_SA(b, h) (((b) * 2 + (h)) * HTB)
#define PG8_SB(b, h) ((4 + (b) * 2 + (h)) * HTB)
#define PG8_STAGE(bufoff, gbase, voff) do { _Pragma("unroll") for (int _i = 0; _i < 2; ++_i) \
        __builtin_amdgcn_global_load_lds((const unsigned*)((const char*)(gbase) + (voff)[_i]), (PG8_LAS unsigned*)(lds + (bufoff) + ldsw + _i * 8192), 16, 0, 0); } while (0)
#define PG8_LDA(dst, b, h) do { _Pragma("unroll") for (int m = 0; m < 4; ++m) _Pragma("unroll") for (int k = 0; k < 2; ++k) dst[m][k] = *(const PG8_LAS bf16x8*)(lds + PG8_SA(b, h) + aoff + m * 2048 + k * 1024); } while (0)
#define PG8_LDB(dst, b, h) do { _Pragma("unroll") for (int n = 0; n < 2; ++n) _Pragma("unroll") for (int k = 0; k < 2; ++k) dst[n][k] = *(const PG8_LAS bf16x8*)(lds + PG8_SB(b, h) + boff + n * 2048 + k * 1024); } while (0)
#define PG8_MMA(ai, bj, At, Bt) do { __builtin_amdgcn_s_setprio(1); _Pragma("unroll") for (int m = 0; m < 4; ++m) _Pragma("unroll") for (int n = 0; n < 2; ++n) _Pragma("unroll") for (int k = 0; k < 2; ++k) \
        acc[ai][bj][m][n] = __builtin_amdgcn_mfma_f32_16x16x32_bf16(Bt[n][k], At[m][k], acc[ai][bj][m][n], 0, 0, 0); __builtin_amdgcn_s_setprio(0); } while (0)
#define PG8_WAIT_V(n) asm volatile("s_waitcnt vmcnt(" #n ")" ::: "memory")
#define PG8_WAIT_L(n) asm volatile("s_waitcnt lgkmcnt(" #n ")" ::: "memory")
#define PG8_BAR __builtin_amdgcn_s_barrier()
#define PG8_SCHED __builtin_amdgcn_sched_barrier(0)
    Unit cur, nxt; int ui = 0;
    if (!S.next(0, cur)) return;
    f32x4 acc[2][2][4][2];
#pragma unroll
    for (int a = 0; a < 2; ++a)
#pragma unroll
        for (int b = 0; b < 2; ++b)
#pragma unroll
            for (int m = 0; m < 4; ++m)
#pragma unroll
                for (int n = 0; n < 2; ++n) acc[a][b][m][n] = (f32x4){0.f, 0.f, 0.f, 0.f};
    bf16x8 At[4][2], B0[2][2], B1[2][2];
    const char* cA = (const char*)g.A + (size_t)cur.pm * tstepA + (size_t)cur.pn * cstepA; const char* cB = (const char*)g.Bt + (size_t)cur.pn * tstepB;
    S.a_ready(cur);
    PG8_STAGE(PG8_SB(0, 0), cB, voffB); PG8_STAGE(PG8_SA(0, 0), cA, voffA); PG8_STAGE(PG8_SB(0, 1), cB + hstepB, voffB); PG8_STAGE(PG8_SA(0, 1), cA + hstepA, voffA);
    if (wr == 1) PG8_BAR;
    PG8_WAIT_V(4); PG8_BAR;
    PG8_STAGE(PG8_SB(1, 0), cB + kstep, voffB); PG8_STAGE(PG8_SA(1, 0), cA + kstep, voffA); PG8_STAGE(PG8_SB(1, 1), cB + hstepB + kstep, voffB);
    PG8_WAIT_V(6); PG8_BAR;
    PG8_STAMP();
    for (;;) {
        const bool has_next = S.next(ui + 1, nxt);
        const char* nA = has_next ? (const char*)g.A + (size_t)nxt.pm * tstepA + (size_t)nxt.pn * cstepA : cA; const char* nB = has_next ? (const char*)g.Bt + (size_t)nxt.pn * tstepB : cB;
        for (int t = 0; t < nt; t += 2) {
            const bool last = (t == nt - 2);
            const char* a1 = cA + (size_t)(t + 1) * kstep;
            const char* a2 = last ? nA : cA + (size_t)(t + 2) * kstep; const char* b2 = last ? nB : cB + (size_t)(t + 2) * kstep;
            const char* a3 = a2 + kstep; const char* b3 = b2 + kstep;
            if (last && has_next) S.a_ready(nxt);
            PG8_LDB(B0, 0, 0); PG8_SCHED; PG8_LDA(At, 0, 0); PG8_STAGE(PG8_SA(1, 1), a1 + hstepA, voffA);
            PG8_WAIT_L(8); PG8_BAR; PG8_WAIT_L(0); PG8_MMA(0, 0, At, B0); PG8_BAR; PG8_SCHED;
            PG8_LDB(B1, 0, 1); PG8_STAGE(PG8_SB(0, 0), b2, voffB);
            PG8_BAR; PG8_WAIT_L(0); PG8_MMA(0, 1, At, B1); PG8_BAR;
            PG8_LDA(At, 0, 1); PG8_STAGE(PG8_SA(0, 0), a2, voffA);
            PG8_BAR; PG8_WAIT_L(0); PG8_MMA(1, 0, At, B0); PG8_BAR; PG8_SCHED;
            PG8_STAGE(PG8_SB(0, 1), b2 + hstepB, voffB);
            PG8_WAIT_V(6); PG8_BAR; PG8_MMA(1, 1, At, B1); PG8_BAR;
            PG8_LDB(B0, 1, 0); PG8_SCHED; PG8_LDA(At, 1, 0); PG8_STAGE(PG8_SA(0, 1), a2 + hstepA, voffA);
            PG8_WAIT_L(8); PG8_BAR; PG8_WAIT_L(0); PG8_MMA(0, 0, At, B0); PG8_BAR; PG8_SCHED;
            PG8_LDB(B1, 1, 1); PG8_STAGE(PG8_SB(1, 0), b3, voffB);
            PG8_BAR; PG8_WAIT_L(0); PG8_MMA(0, 1, At, B1); PG8_BAR;
            PG8_LDA(At, 1, 1); PG8_STAGE(PG8_SA(1, 0), a3, voffA);
            PG8_BAR; PG8_WAIT_L(0); PG8_MMA(1, 0, At, B0); PG8_BAR; PG8_SCHED;
            PG8_STAGE(PG8_SB(1, 1), b3 + hstepB, voffB);
            PG8_WAIT_V(6); PG8_BAR; PG8_MMA(1, 1, At, B1); PG8_BAR;
        }
        PG8_STAMP();
        if constexpr (!Epi::AFTER_DRAIN) { E(acc, cur, wr, wc, fr, fq); S.done(cur); }
        PG8_STAMP();
        if (!has_next) break;
#pragma unroll
        for (int a = 0; a < 2; ++a)
#pragma unroll
            for (int b = 0; b < 2; ++b)
#pragma unroll
                for (int m = 0; m < 4; ++m)
#pragma unroll
                    for (int n = 0; n < 2; ++n) acc[a][b][m][n] = (f32x4){0.f, 0.f, 0.f, 0.f};
        cur = nxt; cA = nA; cB = nB; ++ui;
    }
    PG8_WAIT_V(0);
    if (wr == 0) PG8_BAR;
    PG8_BAR;
    if constexpr (Epi::AFTER_DRAIN) { E.fused(acc, cur, wr, wc, fr, fq, lds, wid, lane); S.done(cur); }
    PG8_STAMP();
#undef PG8_STAMP
#undef PG8_SA
#undef PG8_SB
#undef PG8_STAGE
#undef PG8_LDA
#undef PG8_LDB
#undef PG8_MMA
#undef PG8_WAIT_V
#undef PG8_WAIT_L
#undef PG8_BAR
#undef PG8_SCHED
}
}


using pg8::bf16_t; using pg8::bf16x8; using pg8::f32x4; using pg8::u32x4;
typedef unsigned u32x2 __attribute__((ext_vector_type(2)));
#define LAS __attribute__((address_space(3)))

constexpr int D = 1024, MP = 65536, MSAMP = 512, MT = MP + MSAMP, DFF = 4096;
constexpr int LDS_BYTES = 147472, LDS_BARW = 147456;
constexpr float EPS = 1e-6f;
constexpr size_t WS_WIN = 0, WS_WOUT = WS_WIN + 16777216, WS_WUP = WS_WOUT + 8388608, WS_WDOWN = WS_WUP + 33554432, WS_WPOOL = WS_WDOWN + 33554432,
                 WS_MOD = WS_WPOOL + 1048576, WS_VSS = WS_MOD + 2359296, WS_H = WS_VSS + 8454144, WS_MIX = WS_H + 135266304, WS_Z = WS_MIX + 135266304, WS_X16 = WS_Z + 541065216, WS_BAR = WS_X16 + 135266304, WS_CEN = WS_BAR + 16384, WS_END = WS_CEN + 4096;
constexpr size_t OUT_YS = 67108864, OUT_SPP = 67633152, OUT_SSS = 67878912, OUT_SPS = 69976064;

struct Params { const float* in[17]; float* out; unsigned char* ws; };

__device__ __forceinline__ float bf_lo(unsigned w) { return __uint_as_float(w << 16); }
__device__ __forceinline__ float bf_hi(unsigned w) { return __uint_as_float(w & 0xffff0000u); }
__device__ __forceinline__ void unpack8(const u32x4 w, float (&f)[8]) {
    f[0] = bf_lo(w.x); f[1] = bf_hi(w.x); f[2] = bf_lo(w.y); f[3] = bf_hi(w.y); f[4] = bf_lo(w.z); f[5] = bf_hi(w.z); f[6] = bf_lo(w.w); f[7] = bf_hi(w.w); }
__device__ __forceinline__ u32x4 pack8(const float (&f)[8]) {
    u32x4 w; w.x = pg8::cvt_pk_bf16(f[0], f[1]); w.y = pg8::cvt_pk_bf16(f[2], f[3]); w.z = pg8::cvt_pk_bf16(f[4], f[5]); w.w = pg8::cvt_pk_bf16(f[6], f[7]); return w; }
__device__ __forceinline__ int opaque_tid() { int t = threadIdx.x; asm volatile("" : "+v"(t)); return t; }
__device__ __forceinline__ float wave_sum(float v) {
#pragma unroll
    for (int o = 32; o >= 1; o >>= 1) v += __shfl_xor(v, o);
    return v; }
typedef float f32x2 __attribute__((ext_vector_type(2)));
__device__ __forceinline__ f32x2 gelu2(f32x2 x) {
    const f32x2 t = x * (x * x * (-0.1029432371f) + (-2.3022081982f));
    f32x2 e; e[0] = __builtin_amdgcn_exp2f(t[0]); e[1] = __builtin_amdgcn_exp2f(t[1]);
    const f32x2 d = e + 1.0f;
    f32x2 r; r[0] = __builtin_amdgcn_rcpf(d[0]); r[1] = __builtin_amdgcn_rcpf(d[1]);
    return x * r; }
__device__ __forceinline__ float relu1(float x) { float r; asm("v_max_f32 %0, 0, %1" : "=v"(r) : "v"(x)); return r; }
__device__ __forceinline__ float gelu_tanh(float x) {
    const float y = x * (1.5957691216f + 0.0713548163f * x * x);
    const float e = __builtin_amdgcn_exp2f(-1.4426950409f * y);
    return x * __builtin_amdgcn_rcpf(1.0f + e); }

template <int ACT> struct EpiAct {
    static constexpr bool PERM = true, AFTER_DRAIN = false;
    bf16_t* O; int ldc; float* vss; const float* scale;
    __device__ __forceinline__ void operator()(const f32x4 (&acc)[2][2][4][2], const pg8::Unit& u, int wr, int wc, int fr, int fq) const {
        const int row0 = u.pm * 256 + wr * 64 + fr, col0 = u.pn * 256 + wc * 32 + 8 * fq;
        f32x4 sv[2][2];
#pragma unroll
        for (int bj = 0; bj < 2; ++bj)
#pragma unroll
            for (int n = 0; n < 2; ++n) sv[bj][n] = (ACT == 2 && scale) ? *(const f32x4*)(scale + col0 + bj * 128 + 4 * n) : (f32x4){1.f, 1.f, 1.f, 1.f};
#pragma unroll
        for (int ai = 0; ai < 2; ++ai)
#pragma unroll
            for (int m = 0; m < 4; ++m) {
                const int row = row0 + ai * 128 + m * 16;
                bf16_t* rowp = O + (size_t)row * ldc + col0;
                float ss = 0.f;
#pragma unroll
                for (int bj = 0; bj < 2; ++bj) {
                    f32x4 v0 = acc[ai][bj][m][0], v1 = acc[ai][bj][m][1];
                    if (ACT == 0) {
                        const f32x2 a = gelu2((f32x2){v0[0], v0[1]}), b = gelu2((f32x2){v0[2], v0[3]}), c = gelu2((f32x2){v1[0], v1[1]}), d = gelu2((f32x2){v1[2], v1[3]});
                        v0 = (f32x4){a[0], a[1], b[0], b[1]}; v1 = (f32x4){c[0], c[1], d[0], d[1]};
                        if (u.pn >= 8) { const f32x2 q = a * a + b * b + c * c + d * d; ss += q[0] + q[1]; }
                    }
                    if (ACT == 1) {
#pragma unroll
                        for (int j = 0; j < 4; ++j) { const float a = relu1(v0[j]), b = relu1(v1[j]); v0[j] = a * a; v1[j] = b * b; }
                    }
                    if (ACT == 2) { v0 *= sv[bj][0]; v1 *= sv[bj][1]; }
                    u32x4 w; w.x = pg8::cvt_pk_bf16(v0[0], v0[1]); w.y = pg8::cvt_pk_bf16(v0[2], v0[3]); w.z = pg8::cvt_pk_bf16(v1[0], v1[1]); w.w = pg8::cvt_pk_bf16(v1[2], v1[3]);
                    if (ACT == 2) *(u32x4*)(rowp + bj * 128) = w; else __builtin_nontemporal_store(w, (u32x4*)(rowp + bj * 128));
                }
                if (ACT == 0) {
                    if (u.pn >= 8) { ss += __shfl_xor(ss, 16); ss += __shfl_xor(ss, 32); if (fq == 0) vss[(size_t)row * 32 + (u.pn - 8) * 4 + wc] = ss; }
                }
            }
    }
};

template <int ACT>
__device__ __forceinline__ void sgemm_wide(const bf16_t* A, const bf16_t* Bt, bf16_t* O) {
    const int tid = opaque_tid(), lane = tid & 63, wv = tid >> 6, fr = lane & 15, fq = lane >> 4, wr = wv >> 2, wc = wv & 3;
    for (int t = blockIdx.x; t < 256; t += gridDim.x) {
        const int row0 = MP + (t >> 5) * 64 + wr * 32, col0 = (t & 31) * 128 + wc * 32;
        const bf16_t* ap = A + (size_t)(row0 + fr) * 1024 + 8 * fq;
        const bf16_t* bp = Bt + (size_t)(col0 + fr) * 1024 + 8 * fq;
        f32x4 acc[2][2];
#pragma unroll
        for (int mi = 0; mi < 2; ++mi) { acc[mi][0] = (f32x4){0.f, 0.f, 0.f, 0.f}; acc[mi][1] = acc[mi][0]; }
#pragma unroll 8
        for (int ks = 0; ks < 1024; ks += 32) {
            bf16x8 a[2], b[2];
#pragma unroll
            for (int i = 0; i < 2; ++i) { a[i] = *(const bf16x8*)(ap + (size_t)(16 * i) * 1024 + ks); b[i] = *(const bf16x8*)(bp + (size_t)(16 * i) * 1024 + ks); }
#pragma unroll
            for (int mi = 0; mi < 2; ++mi)
#pragma unroll
                for (int ni = 0; ni < 2; ++ni) acc[mi][ni] = __builtin_amdgcn_mfma_f32_16x16x32_bf16(b[ni], a[mi], acc[mi][ni], 0, 0, 0);
        }
#pragma unroll
        for (int mi = 0; mi < 2; ++mi)
#pragma unroll
            for (int ni = 0; ni < 2; ++ni) {
                f32x4 s = acc[mi][ni];
                if (ACT == 0) { const f32x2 p = gelu2((f32x2){s[0], s[1]}), q = gelu2((f32x2){s[2], s[3]}); s = (f32x4){p[0], p[1], q[0], q[1]}; }
                if (ACT == 1) {
#pragma unroll
                    for (int j = 0; j < 4; ++j) { const float v = fmaxf(s[j], 0.f); s[j] = v * v; }
                }
                u32x2 w; w.x = pg8::cvt_pk_bf16(s[0], s[1]); w.y = pg8::cvt_pk_bf16(s[2], s[3]);
                *(u32x2*)(O + (size_t)(row0 + 16 * mi + fr) * 4096 + col0 + 16 * ni + 4 * fq) = w;
            }
    }
}

template <int ACT>
__device__ __forceinline__ void sgemm_phase(LAS float* red, const bf16_t* A, int lda, int acol, const bf16_t* Bt, int N, int K, bf16_t* O, int ldc, const float* scale) {
    const int tid = opaque_tid(), lane = tid & 63, wv = tid >> 6, fr = lane & 15, fq = lane >> 4;
    const int ntn = N >> 5, ntiles = 8 * ntn, kw = K >> 3;
    for (int t = blockIdx.x; t < ntiles; t += gridDim.x) {
        const int tm = t / ntn, tn = t - tm * ntn, row0 = MP + tm * 64, col0 = tn * 32;
        const bf16_t* ap = A + (size_t)(row0 + fr) * lda + (col0 >> 8) * acol + wv * kw + 8 * fq;
        const bf16_t* bp = Bt + (size_t)(col0 + fr) * K + wv * kw + 8 * fq;
        f32x4 acc[4][2];
#pragma unroll
        for (int mi = 0; mi < 4; ++mi) { acc[mi][0] = (f32x4){0.f, 0.f, 0.f, 0.f}; acc[mi][1] = acc[mi][0]; }
#pragma unroll 4
        for (int ks = 0; ks < kw; ks += 32) {
            bf16x8 a[4], b[2];
#pragma unroll
            for (int mi = 0; mi < 4; ++mi) a[mi] = *(const bf16x8*)(ap + (size_t)(16 * mi) * lda + ks);
#pragma unroll
            for (int ni = 0; ni < 2; ++ni) b[ni] = *(const bf16x8*)(bp + (size_t)(16 * ni) * K + ks);
#pragma unroll
            for (int mi = 0; mi < 4; ++mi)
#pragma unroll
                for (int ni = 0; ni < 2; ++ni) acc[mi][ni] = __builtin_amdgcn_mfma_f32_16x16x32_bf16(b[ni], a[mi], acc[mi][ni], 0, 0, 0);
        }
#pragma unroll
        for (int mi = 0; mi < 4; ++mi)
#pragma unroll
            for (int ni = 0; ni < 2; ++ni) *(LAS f32x4*)(red + ((wv * 64 + 16 * mi + fr) * 36 + 16 * ni + 4 * fq)) = acc[mi][ni];
        __syncthreads();
        {
            const int row = tid >> 3, c4 = (tid & 7) * 4;
            f32x4 s = (f32x4){0.f, 0.f, 0.f, 0.f};
#pragma unroll
            for (int w8 = 0; w8 < 8; ++w8) s += *(const LAS f32x4*)(red + ((w8 * 64 + row) * 36 + c4));
            if (ACT == 0) {
#pragma unroll
                for (int j = 0; j < 4; ++j) s[j] = gelu_tanh(s[j]);
            }
            if (ACT == 1) {
#pragma unroll
                for (int j = 0; j < 4; ++j) { const float a = fmaxf(s[j], 0.f); s[j] = a * a; }
            }
            if (ACT == 2) { if (scale) s *= *(const f32x4*)(scale + col0 + c4); }
            u32x2 w; w.x = pg8::cvt_pk_bf16(s[0], s[1]); w.y = pg8::cvt_pk_bf16(s[2], s[3]);
            *(u32x2*)(O + (size_t)(row0 + row) * ldc + col0 + c4) = w;
        }
        __syncthreads();
    }
}

__device__ __forceinline__ void mod_phase(const Params& P, LAS float* lds) {
    LAS float* sc = lds; LAS float* red = lds + 24576;
    const int tid = opaque_tid(), lane = tid & 63, wv = tid >> 6;
    for (int i = tid; i < 24576; i += 512) { const int b = i >> 10, k = i & 1023; const float c = b < 8 ? P.in[3][b * 1024 + k] : P.in[4][(b - 8) * 1024 + k]; sc[k * 24 + b] = c / (1.0f + __expf(-c)); }
    __syncthreads();
    float* modo = (float*)(P.ws + WS_MOD);
    for (int task = blockIdx.x; task < 768; task += gridDim.x) {
        const int l = task / 192, n0 = (task % 192) * 32, cl = lane & 31, ksl = wv * 2 + (lane >> 5);
        const float* w = P.in[6] + (size_t)l * 1024 * 6144 + n0 + cl;
        float acc[24];
#pragma unroll
        for (int b = 0; b < 24; ++b) acc[b] = 0.f;
        const int k0 = ksl * 64;
#pragma unroll 16
        for (int k = k0; k < k0 + 64; ++k) {
            const float wk = __builtin_nontemporal_load(w + (size_t)k * 6144);
            const LAS f32x4* s4 = (const LAS f32x4*)(sc + k * 24);
#pragma unroll
            for (int q = 0; q < 6; ++q) { const f32x4 s = s4[q]; acc[4 * q + 0] += wk * s[0]; acc[4 * q + 1] += wk * s[1]; acc[4 * q + 2] += wk * s[2]; acc[4 * q + 3] += wk * s[3]; }
        }
#pragma unroll
        for (int b = 0; b < 24; ++b) red[(ksl * 24 + b) * 32 + cl] = acc[b];
        __syncthreads();
        for (int o = tid; o < 768; o += 512) {
            const int b = o >> 5, n = o & 31; float s = 0.f;
#pragma unroll
            for (int w16 = 0; w16 < 16; ++w16) s += red[(w16 * 24 + b) * 32 + n];
            modo[(size_t)(l * 24 + b) * 6144 + n0 + n] = s + P.in[7][l * 6144 + n0 + n];
        }
        __syncthreads();
    }
}

__device__ __forceinline__ void convert_phase(const Params& P, LAS float* lds) {
    const int tid = opaque_tid(), lane = tid & 63, wv = tid >> 6;
    LAS float* tile = lds + wv * 4160;
    for (int t = blockIdx.x * 8 + wv; t < 11392; t += gridDim.x * 8) {
        const float* src; bf16_t* dst; int K, N, loc;
        if (t < 2048)       { src = P.in[8];  dst = (bf16_t*)(P.ws + WS_WIN);   K = 1024; N = 4096; loc = t; }
        else if (t < 3072)  { src = P.in[12]; dst = (bf16_t*)(P.ws + WS_WOUT);  K = 2048; N = 1024; loc = t - 2048; }
        else if (t < 7168)  { src = P.in[15]; dst = (bf16_t*)(P.ws + WS_WUP);   K = 1024; N = 4096; loc = t - 3072; }
        else if (t < 11264) { src = P.in[16]; dst = (bf16_t*)(P.ws + WS_WDOWN); K = 4096; N = 1024; loc = t - 7168; }
        else                { src = P.in[13]; dst = (bf16_t*)(P.ws + WS_WPOOL); K = 256;  N = 256;  loc = t - 11264; }
        const int tn = N >> 6, per = (K >> 6) * tn, mat = loc / per, rem = loc - mat * per, kt = rem / tn, ntile = rem - kt * tn;
        const float* s = src + (size_t)mat * K * N + (size_t)(kt * 64) * N + ntile * 64;
        bf16_t* d = dst + (size_t)mat * K * N + (size_t)(ntile * 64) * K + kt * 64;
        f32x4 v[16];
#pragma unroll
        for (int it = 0; it < 16; ++it) { const int idx = lane + 64 * it, kr = idx >> 4, c4 = (idx & 15) * 4; v[it] = __builtin_nontemporal_load((const f32x4*)(s + (size_t)kr * N + c4)); }
#pragma unroll
        for (int it = 0; it < 16; ++it) { const int idx = lane + 64 * it, kr = idx >> 4, c4 = (idx & 15) * 4;
            tile[kr * 65 + c4 + 0] = v[it][0]; tile[kr * 65 + c4 + 1] = v[it][1]; tile[kr * 65 + c4 + 2] = v[it][2]; tile[kr * 65 + c4 + 3] = v[it][3]; }
        asm volatile("s_waitcnt lgkmcnt(0)" ::: "memory");
#pragma unroll
        for (int it = 0; it < 8; ++it) {
            const int idx = lane + 64 * it, n = idx >> 3, kc = idx & 7; float f[8];
#pragma unroll
            for (int e = 0; e < 8; ++e) f[e] = tile[(8 * kc + e) * 65 + n];
            *(u32x4*)(d + (size_t)n * K + 8 * kc) = pack8(f);
        }
        asm volatile("s_waitcnt lgkmcnt(0)" ::: "memory");
    }
    __syncthreads();
}

typedef _Float16 f16x8 __attribute__((ext_vector_type(8)));
__device__ __forceinline__ void unpack8h(const u32x4 w, float (&f)[8]) { const f16x8 h = __builtin_bit_cast(f16x8, w);
#pragma unroll
    for (int e = 0; e < 8; ++e) f[e] = (float)h[e]; }
__device__ __forceinline__ u32x4 pack8h(const float (&f)[8]) { f16x8 h;
#pragma unroll
    for (int e = 0; e < 8; ++e) h[e] = (_Float16)f[e];
    return __builtin_bit_cast(u32x4, h); }
struct RnCfg { bool has_h, wstate, final_; int jl; };
struct RnRow { u32x4 xh[2], mw[2]; };
__device__ __forceinline__ void rn_load(const Params& P, int row, int lane, RnRow& R) {
    const bf16_t* x16 = (const bf16_t*)(P.ws + WS_X16); const bf16_t* mix = (const bf16_t*)(P.ws + WS_MIX);
#pragma unroll
    for (int hh = 0; hh < 2; ++hh) { R.xh[hh] = __builtin_nontemporal_load((const u32x4*)(x16 + (size_t)row * 1024 + hh * 512 + 8 * lane)); R.mw[hh] = __builtin_nontemporal_load((const u32x4*)(mix + (size_t)row * 1024 + hh * 512 + 8 * lane)); }
}
__device__ __forceinline__ void rn_emit_h(const Params& P, const RnCfg& c, int row, int b, int lane, const float (&ca)[2][8], const float (&cs)[2][8], const float (&x)[2][8]) {
    bf16_t* hbuf = (bf16_t*)(P.ws + WS_H);
    float ss = 0.f;
#pragma unroll
    for (int hh = 0; hh < 2; ++hh)
#pragma unroll
        for (int e = 0; e < 8; ++e) ss += x[hh][e] * x[hh][e];
    ss = wave_sum(ss);
    const float r2 = rsqrtf(ss * (1.0f / 1024.0f) + EPS);
    float hv[2][8];
#pragma unroll
    for (int hh = 0; hh < 2; ++hh) {
#pragma unroll
        for (int e = 0; e < 8; ++e) hv[hh][e] = x[hh][e] * r2 * ca[hh][e] + cs[hh][e];
        *(u32x4*)(hbuf + (size_t)row * 1024 + hh * 512 + 8 * lane) = pack8(hv[hh]);
    }
    if (c.wstate) {
        float* dst = nullptr;
        if (row < MP) { const int rr = row & 8191; if (rr >= 8177) dst = P.out + OUT_SPP + ((size_t)(c.jl * 8 + b) * 15 + (rr - 8177)) * 1024; }
        else { const int rr = (row - MP) & 31; if (rr >= 17) dst = P.out + OUT_SPS + ((size_t)(c.jl * 16 + (b - 8)) * 15 + (rr - 17)) * 1024; }
        if (dst) {
#pragma unroll
            for (int hh = 0; hh < 2; ++hh) { *(f32x4*)(dst + hh * 512 + 8 * lane) = (f32x4){hv[hh][0], hv[hh][1], hv[hh][2], hv[hh][3]}; *(f32x4*)(dst + hh * 512 + 8 * lane + 4) = (f32x4){hv[hh][4], hv[hh][5], hv[hh][6], hv[hh][7]}; }
        }
    }
}
__device__ __forceinline__ void rn_process(const Params& P, const RnCfg& c, int row, int b, int lane, const float (&cg)[2][8], const float (&ca)[2][8], const float (&cs)[2][8], const RnRow& R) {
    float x[2][8], m[2][8]; float ss = 0.f;
#pragma unroll
    for (int hh = 0; hh < 2; ++hh) { unpack8h(R.xh[hh], x[hh]); unpack8(R.mw[hh], m[hh]);
#pragma unroll
        for (int e = 0; e < 8; ++e) ss += m[hh][e] * m[hh][e]; }
    ss = wave_sum(ss);
    const float r1 = rsqrtf(ss * (1.0f / 1024.0f) + EPS);
#pragma unroll
    for (int hh = 0; hh < 2; ++hh)
#pragma unroll
        for (int e = 0; e < 8; ++e) x[hh][e] += m[hh][e] * r1 * cg[hh][e];
    if (c.final_) {
#pragma unroll
        for (int hh = 0; hh < 2; ++hh) { float* dst = P.out + (size_t)row * 1024 + hh * 512 + 8 * lane;
            *(f32x4*)dst = (f32x4){x[hh][0], x[hh][1], x[hh][2], x[hh][3]}; *(f32x4*)(dst + 4) = (f32x4){x[hh][4], x[hh][5], x[hh][6], x[hh][7]}; }
    } else {
        bf16_t* x16 = (bf16_t*)(P.ws + WS_X16);
#pragma unroll
        for (int hh = 0; hh < 2; ++hh) __builtin_nontemporal_store(pack8h(x[hh]), (u32x4*)(x16 + (size_t)row * 1024 + hh * 512 + 8 * lane));
    }
    if (c.has_h) rn_emit_h(P, c, row, b, lane, ca, cs, x);
}
__device__ __forceinline__ void rn_vectors(const Params& P, int li, int ln, int mode, int b, int lane, bool has_mix, bool has_h, float (&cg)[2][8], float (&ca)[2][8], float (&cs)[2][8]) {
    const float* modb = (const float*)(P.ws + WS_MOD); const float* gn = P.in[5];
    const int g_res_idx = li * 4 + (mode == 1 ? 1 : 3), gate_chunk = mode == 1 ? 2 : 5;
    const int g2_idx = ln * 4 + (mode == 1 ? 2 : 0), sc_chunk = mode == 1 ? 4 : 1, sh_chunk = mode == 1 ? 3 : 0;
#pragma unroll
    for (int hh = 0; hh < 2; ++hh)
#pragma unroll
        for (int q = 0; q < 2; ++q) {
            const int col = hh * 512 + 8 * lane + 4 * q;
            f32x4 vg = (f32x4){0.f, 0.f, 0.f, 0.f}, va = vg, vs = vg;
            if (has_mix) vg = *(const f32x4*)(modb + ((size_t)(li * 24 + b) * 6 + gate_chunk) * 1024 + col) * *(const f32x4*)(gn + g_res_idx * 1024 + col);
            if (has_h) { va = *(const f32x4*)(gn + g2_idx * 1024 + col) * (*(const f32x4*)(modb + ((size_t)(ln * 24 + b) * 6 + sc_chunk) * 1024 + col) + 1.0f);
                         vs = *(const f32x4*)(modb + ((size_t)(ln * 24 + b) * 6 + sh_chunk) * 1024 + col); }
#pragma unroll
            for (int e = 0; e < 4; ++e) { cg[hh][4 * q + e] = vg[e]; ca[hh][4 * q + e] = va[e]; cs[hh][4 * q + e] = vs[e]; }
        }
}
__device__ __forceinline__ void resnorm_phase(const Params& P, int li, int mode, int first_task) {
    const int tid = opaque_tid(), lane = tid & 63, wv = tid >> 6;
    RnCfg c;
    c.has_h = !(mode == 2 && li == 3); c.final_ = (mode == 2 && li == 3);
    const int ln = mode == 2 ? li + 1 : li;
    c.wstate = c.has_h && mode != 1 && (ln & 1);
    c.jl = ln >> 1;
    for (int sr = blockIdx.x * 8 + wv; sr < MSAMP; sr += gridDim.x * 8) {
        const int row = MP + sr, b = 8 + (sr >> 5);
        float cg[2][8], ca[2][8], cs[2][8];
        rn_vectors(P, li, ln, mode, b, lane, mode != 0, c.has_h, cg, ca, cs);
        if (mode == 0) {
            bf16_t* x16 = (bf16_t*)(P.ws + WS_X16);
            const float* xs = P.in[1] + (size_t)sr * 1024;
            float x[2][8];
#pragma unroll
            for (int hh = 0; hh < 2; ++hh) { const f32x4 a = __builtin_nontemporal_load((const f32x4*)(xs + hh * 512 + 8 * lane)), bq = __builtin_nontemporal_load((const f32x4*)(xs + hh * 512 + 8 * lane + 4));
                x[hh][0] = a[0]; x[hh][1] = a[1]; x[hh][2] = a[2]; x[hh][3] = a[3]; x[hh][4] = bq[0]; x[hh][5] = bq[1]; x[hh][6] = bq[2]; x[hh][7] = bq[3];
                __builtin_nontemporal_store(pack8h(x[hh]), (u32x4*)(x16 + (size_t)row * 1024 + hh * 512 + 8 * lane)); }
            rn_emit_h(P, c, row, b, lane, ca, cs, x);
        } else { RnRow R; rn_load(P, row, lane, R); rn_process(P, c, row, b, lane, cg, ca, cs, R); }
    }
    for (int t = first_task + blockIdx.x * 8 + wv; t < 2048; t += gridDim.x * 8) {
        const int row0 = t * 32, b = t >> 8;
        float cg[2][8], ca[2][8], cs[2][8];
        rn_vectors(P, li, ln, mode, b, lane, mode != 0, c.has_h, cg, ca, cs);
        if (mode == 0) {
            bf16_t* x16 = (bf16_t*)(P.ws + WS_X16);
#pragma unroll 2
            for (int r = 0; r < 32; ++r) {
                const int row = row0 + r;
                const float* xs = P.in[0] + (size_t)row * 1024;
                float x[2][8];
#pragma unroll
                for (int hh = 0; hh < 2; ++hh) { const f32x4 a = __builtin_nontemporal_load((const f32x4*)(xs + hh * 512 + 8 * lane)), bq = __builtin_nontemporal_load((const f32x4*)(xs + hh * 512 + 8 * lane + 4));
                    x[hh][0] = a[0]; x[hh][1] = a[1]; x[hh][2] = a[2]; x[hh][3] = a[3]; x[hh][4] = bq[0]; x[hh][5] = bq[1]; x[hh][6] = bq[2]; x[hh][7] = bq[3];
                    __builtin_nontemporal_store(pack8h(x[hh]), (u32x4*)(x16 + (size_t)row * 1024 + hh * 512 + 8 * lane)); }
                rn_emit_h(P, c, row, b, lane, ca, cs, x);
            }
        } else {
            RnRow R0, R1, R2, R3;
            rn_load(P, row0, lane, R0); rn_load(P, row0 + 1, lane, R1); rn_load(P, row0 + 2, lane, R2);
#pragma unroll 1
            for (int r = 0; r < 32; r += 4) {
                rn_load(P, row0 + r + 3, lane, R3);
                rn_process(P, c, row0 + r, b, lane, cg, ca, cs, R0);
                if (r + 4 < 32) rn_load(P, row0 + r + 4, lane, R0);
                rn_process(P, c, row0 + r + 1, b, lane, cg, ca, cs, R1);
                if (r + 4 < 32) rn_load(P, row0 + r + 5, lane, R1);
                rn_process(P, c, row0 + r + 2, b, lane, cg, ca, cs, R2);
                if (r + 4 < 32) rn_load(P, row0 + r + 6, lane, R2);
                rn_process(P, c, row0 + r + 3, b, lane, cg, ca, cs, R3);
            }
        }
    }
}

__device__ __forceinline__ void pool_phase(const Params& P, int jl) {
    const int tid = opaque_tid(), lane = tid & 63, wv = tid >> 6;
    const bf16_t* h = (const bf16_t*)(P.ws + WS_H); bf16_t* pooled = (bf16_t*)(P.ws + WS_Z);
    for (int task = blockIdx.x * 8 + wv; task < 2048 + 128; task += gridDim.x * 8) {
        if (task < 2048) {
            const int half = task & 1, row0 = (task >> 1) * 64, pos0 = row0 & 8191;
            const int col = half * 512 + lane * 8, w = 2 << (col >> 8);
            const bf16_t* hp = h + (size_t)row0 * 1024 + col;
            bf16_t* op = pooled + (size_t)row0 * 1024 + col;
            float s[8];
#pragma unroll
            for (int e = 0; e < 8; ++e) s[e] = 0.f;
            if (pos0 > 0) {
#pragma unroll
                for (int k = 1; k < 16; ++k) { float f[8]; unpack8(*(const u32x4*)(hp - (ptrdiff_t)k * 1024), f); const float m = k < w ? 1.f : 0.f;
#pragma unroll
                    for (int e = 0; e < 8; ++e) s[e] += m * f[e]; }
            }
            const float inv_w = 1.0f / (float)w;
            const int lo = pos0 > 0 ? -15 : 0;
#pragma unroll 8
            for (int r = 0; r < 64; ++r) {
                float c[8], f[8]; unpack8(*(const u32x4*)(hp + (size_t)r * 1024), c);
                const int ro = r - w + 1, rc = ro > lo ? ro : lo;
                unpack8(*(const u32x4*)(hp + (ptrdiff_t)rc * 1024), f);
                const float m = ro >= lo ? 1.f : 0.f;
                const int p = pos0 + r;
                const float inv = (p + 1 >= w) ? inv_w : 1.0f / (float)(p + 1);
                float o[8];
#pragma unroll
                for (int e = 0; e < 8; ++e) { s[e] += c[e]; o[e] = s[e] * inv - c[e]; s[e] -= m * f[e]; }
                *(u32x4*)(op + (size_t)r * 1024) = pack8(o);
            }
        } else {
            const int k = task - 2048, seq = k >> 3, half = (k >> 2) & 1, pos0 = (k & 3) * 8;
            const int col = half * 512 + lane * 8, w = 2 << (col >> 8);
            const float* cache = P.in[2] + (size_t)((jl * 16 + seq) * 15) * 1024 + col;
            const bf16_t* hp = h + (size_t)(MP + seq * 32) * 1024 + col;
            bf16_t* op = pooled + (size_t)(MP + seq * 32) * 1024 + col;
            float s[8];
#pragma unroll
            for (int e = 0; e < 8; ++e) s[e] = 0.f;
#pragma unroll
            for (int kk = 1; kk < 16; ++kk) {
                const int p = pos0 - kk; float f[8];
                if (p >= 0) unpack8(*(const u32x4*)(hp + (size_t)p * 1024), f);
                else { const f32x4 a = *(const f32x4*)(cache + (15 + p) * 1024), c = *(const f32x4*)(cache + (15 + p) * 1024 + 4); f[0] = a[0]; f[1] = a[1]; f[2] = a[2]; f[3] = a[3]; f[4] = c[0]; f[5] = c[1]; f[6] = c[2]; f[7] = c[3]; }
                const float m = kk < w ? 1.f : 0.f;
#pragma unroll
                for (int e = 0; e < 8; ++e) s[e] += m * f[e];
            }
            const float inv_w = 1.0f / (float)w;
#pragma unroll
            for (int r = 0; r < 8; ++r) {
                const int p = pos0 + r;
                float c[8], f[8]; unpack8(*(const u32x4*)(hp + (size_t)p * 1024), c);
                const int po = p - w + 1, pc = po > 0 ? po : 0, ci = po < 0 ? 15 + po : 0;
                unpack8(*(const u32x4*)(hp + (size_t)pc * 1024), f);
                const f32x4 ca = *(const f32x4*)(cache + ci * 1024), cb = *(const f32x4*)(cache + ci * 1024 + 4);
                if (po < 0) { f[0] = ca[0]; f[1] = ca[1]; f[2] = ca[2]; f[3] = ca[3]; f[4] = cb[0]; f[5] = cb[1]; f[6] = cb[2]; f[7] = cb[3]; }
                float o[8];
#pragma unroll
                for (int e = 0; e < 8; ++e) { s[e] += c[e]; o[e] = s[e] * inv_w - c[e]; s[e] -= f[e]; }
                *(u32x4*)(op + (size_t)p * 1024) = pack8(o);
            }
        }
    }
}

__device__ __forceinline__ unsigned off_b(unsigned row, unsigned ch) { return 256u * row + 16u * (ch ^ (((row & 3) << 2) | ((row >> 2) & 3))); }
__device__ __forceinline__ unsigned tr_addr16(unsigned lane, unsigned c, unsigned ks, unsigned t) {
    const unsigned g = lane >> 4, q = (lane & 15) >> 2, p = lane & 3;
    return off_b(32 * ks + 8 * g + 4 * t + q, 2 * c + (p >> 1)) + 8 * (p & 1);
}
__device__ __forceinline__ bf16x8 tr_read_pair(unsigned a0, unsigned a1) {
    u32x2 lo, hi;
    asm volatile("ds_read_b64_tr_b16 %0, %2\n\tds_read_b64_tr_b16 %1, %3\n\ts_waitcnt lgkmcnt(0)" : "=&v"(lo), "=&v"(hi) : "v"(a0), "v"(a1) : "memory");
    u32x4 w; w.x = lo.x; w.y = lo.y; w.z = hi.x; w.w = hi.y;
    return __builtin_bit_cast(bf16x8, w);
}

template <bool SAMP>
__device__ __forceinline__ void gate_unit(const LAS unsigned char* wl, const float (&bsl)[8], bf16_t* z, int r0, int g, unsigned img, int lane, int wv) {
    constexpr int NIH = SAMP ? 1 : 2, NI = SAMP ? 2 : 4, NKS = SAMP ? 1 : 4;
    const int fr = lane & 15, fq = lane >> 4, half = wv >> 2;
#pragma unroll
    for (int n = 0; n < 2; ++n) {
        const unsigned c = 2 * (wv & 3) + n;
        bf16_t* ubase = z + (size_t)(r0 + fr) * 4096 + g * 256 + half * 128 + 16 * c + 4 * fq;
        u32x2 uw[NIH * NI];
#pragma unroll
        for (int it = 0; it < NIH * NI; ++it) uw[it] = *(const u32x2*)(ubase + (size_t)(16 * it) * 4096);
        bf16x8 vf[NKS];
        if (SAMP) vf[0] = tr_read_pair(img + half * 32768 + tr_addr16(lane, c, 0, 0), img + half * 32768 + tr_addr16(lane, c, 0, 1));
        else {
            u32x2 q[8]; unsigned ad[8];
#pragma unroll
            for (int i = 0; i < 8; ++i) ad[i] = img + half * 32768 + tr_addr16(lane, c, i >> 1, i & 1);
            asm volatile("ds_read_b64_tr_b16 %0, %8\n\tds_read_b64_tr_b16 %1, %9\n\tds_read_b64_tr_b16 %2, %10\n\tds_read_b64_tr_b16 %3, %11\n\t"
                         "ds_read_b64_tr_b16 %4, %12\n\tds_read_b64_tr_b16 %5, %13\n\tds_read_b64_tr_b16 %6, %14\n\tds_read_b64_tr_b16 %7, %15\n\ts_waitcnt lgkmcnt(0)"
                         : "=&v"(q[0]), "=&v"(q[1]), "=&v"(q[2]), "=&v"(q[3]), "=&v"(q[4]), "=&v"(q[5]), "=&v"(q[6]), "=&v"(q[7])
                         : "v"(ad[0]), "v"(ad[1]), "v"(ad[2]), "v"(ad[3]), "v"(ad[4]), "v"(ad[5]), "v"(ad[6]), "v"(ad[7]) : "memory");
#pragma unroll
            for (int ks = 0; ks < NKS; ++ks) { u32x4 w; w.x = q[2 * ks].x; w.y = q[2 * ks].y; w.z = q[2 * ks + 1].x; w.w = q[2 * ks + 1].y; vf[ks] = __builtin_bit_cast(bf16x8, w); }
        }
#pragma unroll
        for (int ih = 0; ih < NIH; ++ih) {
            f32x4 acc[NI];
#pragma unroll
            for (int ii = 0; ii < NI; ++ii) acc[ii] = (f32x4){0.f, 0.f, 0.f, 0.f};
#pragma unroll
            for (int ii = 0; ii < NI; ++ii)
#pragma unroll
                for (int ks = 0; ks < NKS; ++ks)
                    if (SAMP || ks < 2 || ih == 1) acc[ii] = __builtin_amdgcn_mfma_f32_16x16x32_bf16(vf[ks], *(const LAS bf16x8*)(wl + (16 * (ih * 4 + ii) + fr) * 272 + (32 * ks + 8 * fq) * 2), acc[ii], 0, 0, 0);
#pragma unroll
            for (int ii = 0; ii < NI; ++ii) {
                const int it = ih * 4 + ii;
                const f32x4 a = acc[ii] + bsl[it];
                u32x2 ow; ow.x = pg8::cvt_pk_bf16(bf_lo(uw[it].x) * a[0], bf_hi(uw[it].x) * a[1]); ow.y = pg8::cvt_pk_bf16(bf_lo(uw[it].y) * a[2], bf_hi(uw[it].y) * a[3]);
                *(u32x2*)(ubase + (size_t)(16 * it) * 4096) = ow;
            }
        }
    }
}

__device__ __forceinline__ void gate_phase(const Params& P, int jl, LAS unsigned char* lds) {
    const int tid = opaque_tid(), lane = tid & 63, wv = tid >> 6, fr = lane & 15, fq = lane >> 4;
    const int g = blockIdx.x & 7, cstride = gridDim.x >> 3;
    bf16_t* z = (bf16_t*)(P.ws + WS_Z);
    const float* vss = (const float*)(P.ws + WS_VSS);
    LAS float* rstd_l = (LAS float*)(lds + 65536);
    const unsigned img = (unsigned)(size_t)lds;
    LAS unsigned char* wl = lds + 66560;
    {
        const float* wsg = P.in[10] + (size_t)(jl * 8 + g) * 128 * 128 + (tid >> 2) * 128 + (tid & 3) * 32;
#pragma unroll
        for (int q = 0; q < 4; ++q) {
            const f32x4 a = *(const f32x4*)(wsg + 8 * q), b = *(const f32x4*)(wsg + 8 * q + 4);
            u32x4 w; w.x = pg8::cvt_pk_bf16(a[0], a[1]); w.y = pg8::cvt_pk_bf16(a[2], a[3]); w.z = pg8::cvt_pk_bf16(b[0], b[1]); w.w = pg8::cvt_pk_bf16(b[2], b[3]);
            *(LAS u32x4*)(wl + (tid >> 2) * 272 + ((tid & 3) * 32 + 8 * q) * 2) = w;
        }
    }
    float bsl[8];
#pragma unroll
    for (int it = 0; it < 8; ++it) bsl[it] = P.in[11][(jl * 8 + g) * 128 + 16 * it + fr];
    const int piece = tid & 31, vrow = tid >> 2, vpart = tid & 3;
    float gv[8];
    { const f32x4 a = *(const f32x4*)(P.in[9] + jl * 2048 + g * 256 + piece * 8), b = *(const f32x4*)(P.in[9] + jl * 2048 + g * 256 + piece * 8 + 4);
      gv[0] = a[0]; gv[1] = a[1]; gv[2] = a[2]; gv[3] = a[3]; gv[4] = b[0]; gv[5] = b[1]; gv[6] = b[2]; gv[7] = b[3]; }
    u32x4 vpre[8]; f32x4 spre[2];
#define GATE_PREFETCH(chn) do { const bool sp_ = (chn) >= 512; const int nit_ = sp_ ? 2 : 8, r0_ = sp_ ? MP + ((chn) - 512) * 32 : (chn) * 128; \
        _Pragma("unroll") for (int it_ = 0; it_ < 8; ++it_) if (it_ < nit_) vpre[it_] = __builtin_nontemporal_load((const u32x4*)(z + (size_t)(r0_ + ((tid + 512 * it_) >> 5)) * 4096 + 2048 + g * 256 + piece * 8)); \
        if (!sp_) { spre[0] = *(const f32x4*)(vss + (size_t)(r0_ + vrow) * 32 + vpart * 8); spre[1] = *(const f32x4*)(vss + (size_t)(r0_ + vrow) * 32 + vpart * 8 + 4); } } while (0)
    int ch = blockIdx.x >> 3;
    if (ch < 528) GATE_PREFETCH(ch);
    for (; ch < 528; ch += cstride) {
        const bool samp = ch >= 512; const int nit = samp ? 2 : 8, r0 = samp ? MP + (ch - 512) * 32 : ch * 128;
        if (samp) {
            const int j = tid >> 4, part = tid & 15; float ss = 0.f;
            const bf16_t* vp = z + (size_t)(r0 + j) * 4096 + 2048 + part * 128;
#pragma unroll
            for (int i = 0; i < 16; ++i) { float f[8]; unpack8(*(const u32x4*)(vp + 8 * i), f);
#pragma unroll
                for (int e = 0; e < 8; ++e) ss += f[e] * f[e]; }
            ss += __shfl_xor(ss, 1); ss += __shfl_xor(ss, 2); ss += __shfl_xor(ss, 4); ss += __shfl_xor(ss, 8);
            if (part == 0) rstd_l[j] = rsqrtf(ss * (1.0f / 2048.0f) + EPS);
        } else {
            float s = ((spre[0][0] + spre[0][1]) + (spre[0][2] + spre[0][3])) + ((spre[1][0] + spre[1][1]) + (spre[1][2] + spre[1][3]));
            s += __shfl_xor(s, 1); s += __shfl_xor(s, 2);
            if (vpart == 0) rstd_l[vrow] = rsqrtf(s * (1.0f / 2048.0f) + EPS);
        }
        __syncthreads();
#pragma unroll
        for (int it = 0; it < 8; ++it) {
            if (it < nit) {
                const int j = (tid + 512 * it) >> 5;
                float f[8]; unpack8(vpre[it], f);
                const float rs = rstd_l[j];
#pragma unroll
                for (int e = 0; e < 8; ++e) f[e] = f[e] * rs * gv[e];
                if (samp) {
                    float* dst = P.out + OUT_SSS + ((size_t)(jl * 16 + (ch - 512)) * 32 + j) * 2048 + g * 256 + piece * 8;
                    *(f32x4*)dst = (f32x4){f[0], f[1], f[2], f[3]}; *(f32x4*)(dst + 4) = (f32x4){f[4], f[5], f[6], f[7]};
                }
                *(LAS u32x4*)(lds + (piece >> 4) * 32768 + off_b((unsigned)j, (unsigned)(piece & 15))) = pack8(f);
            }
        }
        __syncthreads();
        { const int chn = ch + cstride; if (chn < 528) GATE_PREFETCH(chn); }
        if (samp) gate_unit<true>(wl, bsl, z, r0, g, img, lane, wv);
        else gate_unit<false>(wl, bsl, z, r0, g, img, lane, wv);
        __syncthreads();
    }
#undef GATE_PREFETCH
}

#define XB_TMO      128
#define XB_XCNT(j)  (256  + 64 * (j))
#define XB_XSUB(j)  (1280 + 64 * (j))
#define XB_XGEN(j)  (2304 + 64 * (j))
#define XB_TOP      3328
#define XB_TOPGEN   3392
#define XCD_BAR_WORDS 3456
#define XB_SPIN_CAP (1u << 18)

__device__ __forceinline__ unsigned xb_ld(unsigned* p)              { return __hip_atomic_load(p, __ATOMIC_RELAXED, __HIP_MEMORY_SCOPE_AGENT); }
__device__ __forceinline__ unsigned xb_add(unsigned* p, unsigned v) { return __hip_atomic_fetch_add(p, v, __ATOMIC_RELAXED, __HIP_MEMORY_SCOPE_AGENT); }
__device__ __forceinline__ unsigned xb_xcc_id() { return (unsigned)__builtin_amdgcn_s_getreg((3 << 11) | 20) & 0xFu; }
#define XB_SPIN(cond, bar) do { unsigned _sp = 0; while (cond) { __builtin_amdgcn_s_sleep(1); \
    if ((++_sp & 255u) == 0u) { if (xb_ld(&(bar)[XB_TMO])) break; if (_sp > XB_SPIN_CAP) { atomicAdd(&(bar)[XB_TMO], 1u); break; } } } } while (0)

struct XcdBarrier {
    unsigned* bar; unsigned x;
    volatile LAS unsigned* st;
};

__device__ __forceinline__ XcdBarrier xcd_barrier_post(unsigned* bar, volatile LAS unsigned* st) {
    XcdBarrier b; b.bar = bar; b.x = xb_xcc_id(); b.st = st;
    if (threadIdx.x == 0) (void)xb_add(&bar[XB_XCNT(b.x)], 1u);
    return b;
}
__device__ __forceinline__ void xcd_barrier_complete(unsigned* bar, unsigned x, unsigned& nloc, unsigned& nx) {
    const unsigned G = gridDim.x * gridDim.y * gridDim.z;
    unsigned sum, cnt, mine, sp = 0u;
    for (;;) {
        sum = 0u; cnt = 0u; mine = 0u;
#pragma unroll
        for (unsigned j = 0; j < 16; ++j) { const unsigned c = xb_ld(&bar[XB_XCNT(j)]); sum += c; cnt += (c > 0u) ? 1u : 0u; mine = (j == x) ? c : mine; }
        if (sum == G) break;
        __builtin_amdgcn_s_sleep(1);
        if ((++sp & 255u) == 0u) { if (xb_ld(&bar[XB_TMO])) break; if (sp > XB_SPIN_CAP) { atomicAdd(&bar[XB_TMO], 1u); break; } }
    }
    nloc = mine > 0u ? mine : 1u; nx = cnt > 0u ? cnt : 1u;
}

__device__ __forceinline__ void xcd_barrier(const XcdBarrier& b) {
    asm volatile("s_waitcnt vmcnt(0)" ::: "memory");
    __syncthreads();
    if (threadIdx.x == 0) {
        unsigned* bar = b.bar;
        __builtin_amdgcn_s_waitcnt(0);
        unsigned nloc = b.st[0], nx = b.st[1];
        if (nloc == 0u) { xcd_barrier_complete(bar, b.x, nloc, nx); b.st[0] = nloc; b.st[1] = nx; }
        const unsigned old = xb_add(&bar[XB_XSUB(b.x)], 1u);
        const unsigned gen = old / nloc;
        if (old + 1u == (gen + 1u) * nloc) {
            __builtin_amdgcn_fence(__ATOMIC_RELEASE, "agent");
            asm volatile("s_waitcnt vmcnt(0)" ::: "memory");
            const unsigned og = xb_add(&bar[XB_TOP], 1u);
            const unsigned tg = og / nx;
            if (og + 1u == (tg + 1u) * nx) xb_add(&bar[XB_TOPGEN], 1u);
            else XB_SPIN(xb_ld(&bar[XB_TOPGEN]) == tg, bar);
            __builtin_amdgcn_fence(__ATOMIC_ACQUIRE, "agent");
            xb_add(&bar[XB_XGEN(b.x)], 1u);
            asm volatile("s_waitcnt vmcnt(0)" ::: "memory");
        } else {
            XB_SPIN(xb_ld(&bar[XB_XGEN(b.x)]) == gen, bar);
            __builtin_amdgcn_fence(__ATOMIC_ACQUIRE, "agent");
            asm volatile("s_waitcnt vmcnt(0)" ::: "memory");
        }
    }
    __syncthreads();
}


__global__ void __launch_bounds__(512, 2) mega(Params P) {
    extern __shared__ __attribute__((aligned(16))) unsigned char lds_raw[];
    cg::grid_group grid = cg::this_grid();
    LAS unsigned char* lds = (LAS unsigned char*)lds_raw;
    bf16_t* hbuf = (bf16_t*)(P.ws + WS_H); bf16_t* zbuf = (bf16_t*)(P.ws + WS_Z); bf16_t* mixbuf = (bf16_t*)(P.ws + WS_MIX);
    const int G = gridDim.x;
    if (threadIdx.x < 4) ((LAS unsigned*)(lds + LDS_BARW))[threadIdx.x] = 0u;
    __syncthreads();
    const XcdBarrier xbar = xcd_barrier_post((unsigned*)(P.ws + WS_BAR), (volatile LAS unsigned*)(lds + LDS_BARW));
    unsigned* cen = (unsigned*)(P.ws + WS_CEN);
    if (threadIdx.x == 0) ((LAS unsigned*)(lds + LDS_BARW))[2] = __hip_atomic_fetch_add(cen + 64 * xbar.x, 1u, __ATOMIC_RELAXED, __HIP_MEMORY_SCOPE_AGENT);

    mod_phase(P, (LAS float*)lds);
    convert_phase(P, (LAS float*)lds);
    grid.sync();
    int bid = blockIdx.x;
    {
        bool even = true;
#pragma unroll
        for (int j = 0; j < 8; ++j) even = even && (__hip_atomic_load(cen + 64 * j, __ATOMIC_RELAXED, __HIP_MEMORY_SCOPE_AGENT) == (unsigned)(G >> 3));
        const unsigned rank = ((LAS unsigned*)(lds + LDS_BARW))[2];
        if (even && (G & 7) == 0 && xbar.x < 8u) bid = (int)(xbar.x + 8u * rank);
    }
    resnorm_phase(P, 0, 0, 0);
    xcd_barrier(xbar);
#pragma unroll 1
    for (int li = 0; li < 4; ++li) {
        const int jl = li >> 1;
        pg8::Gemm gm; const float* scale = nullptr;
        if ((li & 1) == 0) {
            {
                pg8::Gemm g{hbuf, (const bf16_t*)(P.ws + WS_WIN) + (size_t)jl * 4096 * 1024, MP, 4096, 1024, 1024, 0};
                sgemm_wide<0>(g.A, g.Bt, zbuf);
                pg8::StaticOrder S; S.init(MP, 4096, G, bid);
                EpiAct<0> E{zbuf, 4096, (float*)(P.ws + WS_VSS), nullptr};
                pg8::gemm_phase<EpiAct<0>, pg8::StaticOrder>(lds, g, S, E);
            }
            xcd_barrier(xbar);
            gate_phase(P, jl, lds);
            xcd_barrier(xbar);
            gm = pg8::Gemm{zbuf, (const bf16_t*)(P.ws + WS_WOUT) + (size_t)jl * 1024 * 2048, MP, 1024, 2048, 4096, 0};
        } else {
            pool_phase(P, jl);
            xcd_barrier(xbar);
            gm = pg8::Gemm{zbuf, (const bf16_t*)(P.ws + WS_WPOOL) + (size_t)jl * 1024 * 256, MP, 1024, 256, 1024, 256};
            scale = P.in[14] + jl * 1024;
        }
#pragma unroll 1
        for (int pass = 0; pass < 2; ++pass) {
            {
                sgemm_phase<2>((LAS float*)lds, gm.A, gm.lda, gm.acol, gm.Bt, gm.N, gm.K, mixbuf, 1024, scale);
                pg8::StaticOrder S; S.init(MP, 1024, G, bid);
                EpiAct<2> E{mixbuf, 1024, nullptr, scale};
                pg8::gemm_phase<EpiAct<2>, pg8::StaticOrder>(lds, gm, S, E);
            }
            xcd_barrier(xbar);
            resnorm_phase(P, li, pass + 1, 0);
            xcd_barrier(xbar);
            if (pass == 0) {
                {
                    pg8::Gemm g{hbuf, (const bf16_t*)(P.ws + WS_WUP) + (size_t)li * 4096 * 1024, MP, 4096, 1024, 1024, 0};
                    sgemm_wide<1>(g.A, g.Bt, zbuf);
                    pg8::StaticOrder S; S.init(MP, 4096, G, bid);
                    EpiAct<1> E{zbuf, 4096, nullptr, nullptr};
                    pg8::gemm_phase<EpiAct<1>, pg8::StaticOrder>(lds, g, S, E);
                }
                xcd_barrier(xbar);
                gm = pg8::Gemm{zbuf, (const bf16_t*)(P.ws + WS_WDOWN) + (size_t)li * 1024 * 4096, MP, 1024, 4096, 4096, 0};
                scale = nullptr;
            }
        }
    }
}

extern "C" void kernel_launch(void* const* d_in, const int* in_sizes, int n_in, void* d_out, int out_size, void* d_ws, size_t ws_size, hipStream_t stream) {
    static int grid = 0;
    if (grid == 0) {
        if (n_in != 17 || ws_size < WS_END) { fprintf(stderr, "kernel_launch: unexpected n_in %d / ws_size %zu (need %zu)\n", n_in, ws_size, (size_t)WS_END); grid = -1; return; }
        int dev = 0, cus = 0, per_cu = 0;
        hipGetDevice(&dev);
        hipDeviceGetAttribute(&cus, hipDeviceAttributeMultiprocessorCount, dev);
        if (hipFuncSetAttribute((const void*)mega, hipFuncAttributeMaxDynamicSharedMemorySize, LDS_BYTES) != hipSuccess) { fprintf(stderr, "kernel_launch: hipFuncSetAttribute failed\n"); grid = -1; return; }
        if (hipOccupancyMaxActiveBlocksPerMultiprocessor(&per_cu, (const void*)mega, 512, LDS_BYTES) != hipSuccess || per_cu < 1) { fprintf(stderr, "kernel_launch: occupancy query gave %d\n", per_cu); per_cu = 1; (void)hipGetLastError(); }
        grid = (cus * per_cu) & ~7;
        if (grid < 8) { grid = -1; return; }
    }
    if (grid < 0) return;
    Params p{};
    for (int i = 0; i < 17; ++i) p.in[i] = (const float*)d_in[i];
    p.out = (float*)d_out; p.ws = (unsigned char*)d_ws;
    if (hipMemsetAsync((char*)d_ws + WS_BAR, 0, 16384 + 4096, stream) != hipSuccess) { fprintf(stderr, "kernel_launch: memset of barrier words failed\n"); return; }
    void* args[] = {&p};
    hipError_t e = hipLaunchCooperativeKernel((const void*)mega, dim3(grid), dim3(512), args, LDS_BYTES, stream);
    if (e != hipSuccess) fprintf(stderr, "cooperative launch failed: %s (grid %d)\n", hipGetErrorString(e), grid);
}
```

```cpp
#include <hip/hip_runtime.h>
#include <hip/hip_cooperative_groups.h>
#include <cstdio>
namespace cg = cooperative_groups;

namespace pg8 {
#define PG8_LAS __attribute__((address_space(3)))
typedef unsigned short bf16_t;
typedef short bf16x8 __attribute__((ext_vector_type(8)));
typedef float f32x4 __attribute__((ext_vector_type(4)));
typedef unsigned u32x4 __attribute__((ext_vector_type(4)));
constexpr int BM = 256, BK = 64, HALF = 128, HTB = HALF * BK * 2  , STAGE_BYTES = 8 * HTB, NXCD = 8, WGM = 8;

__host__ __device__ __forceinline__ int lds_byte(int r, int c) { const int st = (r >> 4) * 2 + (c >> 5), rr = r & 15, cc = c & 31, ob = rr * 64 + cc * 2; return st * 1024 + (ob ^ (((ob >> 9) & 1) << 5)); }
__host__ __device__ __forceinline__ void stage_rc(int b, int& R, int& C) { const int st = b / 1024, sb = b % 1024, swz = sb ^ (((sb >> 9) & 1) << 5); R = (st >> 1) * 16 + swz / 64; C = (st & 1) * 32 + (swz % 64) / 2; }
__host__ __device__ __forceinline__ int perm32(int rho) { const int n = rho >> 4, i = rho & 15; return 8 * (i >> 2) + 4 * n + (i & 3); }

struct Unit { int pm, pn; };
struct Gemm { const bf16_t* A; const bf16_t* Bt; int M, N, K, lda, acol; };

struct StaticOrder {
    int nM, nN, nwg, G, c;
    __host__ __device__ void init(int M, int N, int G_, int c_) { nM = M / BM; nN = N / BM; nwg = nM * nN; G = G_; c = c_; }
    __host__ __device__ bool next(int i, Unit& u) const {
        const long L = (long)i * G + c; if (L >= nwg) return false;
        int wgid = (int)L; { const int q = nwg / NXCD, r = nwg % NXCD, xcd = wgid % NXCD, off = wgid / NXCD; wgid = (xcd < r ? xcd * (q + 1) : r * (q + 1) + (xcd - r) * q) + off; }
        const int nig = WGM * nN, gid = wgid / nig, fm = gid * WGM, gsz = (nM - fm) < WGM ? (nM - fm) : WGM;
        u.pm = fm + ((wgid % nig) % gsz); u.pn = (wgid % nig) / gsz; return true;
    }
    __device__ __forceinline__ void a_ready(const Unit&) const {}
    __device__ __forceinline__ void done(const Unit&) const {}
};

__device__ __forceinline__ unsigned cvt_pk_bf16(float lo, float hi) { unsigned r; asm("v_cvt_pk_bf16_f32 %0, %1, %2" : "=v"(r) : "v"(lo), "v"(hi)); return r; }
template <class Epi, class Sched>
__device__ __forceinline__ void gemm_phase(PG8_LAS unsigned char* lds, const Gemm g, const Sched& S, const Epi& E) {
    int tid_ = threadIdx.x; asm volatile("" : "+v"(tid_));
    const int tid = tid_, wid = __builtin_amdgcn_readfirstlane(tid >> 6), lane = tid & 63, wr = wid >> 2, wc = wid & 3, fr = lane & 15, fq = lane >> 4;
    const int K = g.K, nt = K / BK;
#define PG8_STAMP() do { } while (0)
    PG8_STAMP();
    unsigned voffA[2], voffB[2];
#pragma unroll
    for (int i = 0; i < 2; ++i) { int R, C; stage_rc(tid * 16 + i * 8192, R, C); const int Rb = Epi::PERM ? ((R & ~31) + perm32(R & 31)) : R;
        voffA[i] = (unsigned)(R * g.lda + C) * 2u; voffB[i] = (unsigned)(Rb * K + C) * 2u; }
    const size_t kstep = (size_t)(BK * 2);
    const size_t hstepA = (size_t)HALF * g.lda * 2, hstepB = (size_t)HALF * K * 2;
    const size_t tstepA = 2 * hstepA, tstepB = 2 * hstepB, cstepA = (size_t)g.acol * 2;
    const unsigned ldsw = (unsigned)wid * 1024u;
    const int aoff = lds_byte(wr * 64 + fr, fq * 8), boff = lds_byte(wc * 32 + fr, fq * 8);
#define PG8_SA(b, h) (((b) * 2 + (h)) * HTB)
#define PG8_SB(b, h) ((4 + (b) * 2 + (h)) * HTB)
#define PG8_STAGE(bufoff, gbase, voff) do { _Pragma("unroll") for (int _i = 0; _i < 2; ++_i) \
        __builtin_amdgcn_global_load_lds((const unsigned*)((const char*)(gbase) + (voff)[_i]), (PG8_LAS unsigned*)(lds + (bufoff) + ldsw + _i * 8192), 16, 0, 0); } while (0)
#define PG8_LDA(dst, b, h) do { _Pragma("unroll") for (int m = 0; m < 4; ++m) _Pragma("unroll") for (int k = 0; k < 2; ++k) dst[m][k] = *(const PG8_LAS bf16x8*)(lds + PG8_SA(b, h) + aoff + m * 2048 + k * 1024); } while (0)
#define PG8_LDB(dst, b, h) do { _Pragma("unroll") for (int n = 0; n < 2; ++n) _Pragma("unroll") for (int k = 0; k < 2; ++k) dst[n][k] = *(const PG8_LAS bf16x8*)(lds + PG8_SB(b, h) + boff + n * 2048 + k * 1024); } while (0)
#define PG8_MMA(ai, bj, At, Bt) do { __builtin_amdgcn_s_setprio(1); _Pragma("unroll") for (int m = 0; m < 4; ++m) _Pragma("unroll") for (int n = 0; n < 2; ++n) _Pragma("unroll") for (int k = 0; k < 2; ++k) \
        acc[ai][bj][m][n] = __builtin_amdgcn_mfma_f32_16x16x32_bf16(Bt[n][k], At[m][k], acc[ai][bj][m][n], 0, 0, 0); __builtin_amdgcn_s_setprio(0); } while (0)
#define PG8_WAIT_V(n) asm volatile("s_waitcnt vmcnt(" #n ")" ::: "memory")
#define PG8_WAIT_L(n) asm volatile("s_waitcnt lgkmcnt(" #n ")" ::: "memory")
#define PG8_BAR __builtin_amdgcn_s_barrier()
#define PG8_SCHED __builtin_amdgcn_sched_barrier(0)
    Unit cur, nxt; int ui = 0;
    if (!S.next(0, cur)) return;
    f32x4 acc[2][2][4][2];
#pragma unroll
    for (int a = 0; a < 2; ++a)
#pragma unroll
        for (int b = 0; b < 2; ++b)
#pragma unroll
            for (int m = 0; m < 4; ++m)
#pragma unroll
                for (int n = 0; n < 2; ++n) acc[a][b][m][n] = (f32x4){0.f, 0.f, 0.f, 0.f};
    bf16x8 At[4][2], B0[2][2], B1[2][2];
    const char* cA = (const char*)g.A + (size_t)cur.pm * tstepA + (size_t)cur.pn * cstepA; const char* cB = (const char*)g.Bt + (size_t)cur.pn * tstepB;
    S.a_ready(cur);
    PG8_STAGE(PG8_SB(0, 0), cB, voffB); PG8_STAGE(PG8_SA(0, 0), cA, voffA); PG8_STAGE(PG8_SB(0, 1), cB + hstepB, voffB); PG8_STAGE(PG8_SA(0, 1), cA + hstepA, voffA);
    if (wr == 1) PG8_BAR;
    PG8_WAIT_V(4); PG8_BAR;
    PG8_STAGE(PG8_SB(1, 0), cB + kstep, voffB); PG8_STAGE(PG8_SA(1, 0), cA + kstep, voffA); PG8_STAGE(PG8_SB(1, 1), cB + hstepB + kstep, voffB);
    PG8_WAIT_V(6); PG8_BAR;
    PG8_STAMP();
    for (;;) {
        const bool has_next = S.next(ui + 1, nxt);
        const char* nA = has_next ? (const char*)g.A + (size_t)nxt.pm * tstepA + (size_t)nxt.pn * cstepA : cA; const char* nB = has_next ? (const char*)g.Bt + (size_t)nxt.pn * tstepB : cB;
        for (int t = 0; t < nt; t += 2) {
            const bool last = (t == nt - 2);
            const char* a1 = cA + (size_t)(t + 1) * kstep;
            const char* a2 = last ? nA : cA + (size_t)(t + 2) * kstep; const char* b2 = last ? nB : cB + (size_t)(t + 2) * kstep;
            const char* a3 = a2 + kstep; const char* b3 = b2 + kstep;
            if (last && has_next) S.a_ready(nxt);
            PG8_LDB(B0, 0, 0); PG8_SCHED; PG8_LDA(At, 0, 0); PG8_STAGE(PG8_SA(1, 1), a1 + hstepA, voffA);
            PG8_WAIT_L(8); PG8_BAR; PG8_WAIT_L(0); PG8_MMA(0, 0, At, B0); PG8_BAR; PG8_SCHED;
            PG8_LDB(B1, 0, 1); PG8_STAGE(PG8_SB(0, 0), b2, voffB);
            PG8_BAR; PG8_WAIT_L(0); PG8_MMA(0, 1, At, B1); PG8_BAR;
            PG8_LDA(At, 0, 1); PG8_STAGE(PG8_SA(0, 0), a2, voffA);
            PG8_BAR; PG8_WAIT_L(0); PG8_MMA(1, 0, At, B0); PG8_BAR; PG8_SCHED;
            PG8_STAGE(PG8_SB(0, 1), b2 + hstepB, voffB);
            PG8_WAIT_V(6); PG8_BAR; PG8_MMA(1, 1, At, B1); PG8_BAR;
            PG8_LDB(B0, 1, 0); PG8_SCHED; PG8_LDA(At, 1, 0); PG8_STAGE(PG8_SA(0, 1), a2 + hstepA, voffA);
            PG8_WAIT_L(8); PG8_BAR; PG8_WAIT_L(0); PG8_MMA(0, 0, At, B0); PG8_BAR; PG8_SCHED;
            PG8_LDB(B1, 1, 1); PG8_STAGE(PG8_SB(1, 0), b3, voffB);
            PG8_BAR; PG8_WAIT_L(0); PG8_MMA(0, 1, At, B1); PG8_BAR;
            PG8_LDA(At, 1, 1); PG8_STAGE(PG8_SA(1, 0), a3, voffA);
            PG8_BAR; PG8_WAIT_L(0); PG8_MMA(1, 0, At, B0); PG8_BAR; PG8_SCHED;
            PG8_STAGE(PG8_SB(1, 1), b3 + hstepB, voffB);
            PG8_WAIT_V(6); PG8_BAR; PG8_MMA(1, 1, At, B1); PG8_BAR;
        }
        PG8_STAMP();
        if constexpr (!Epi::AFTER_DRAIN) { E(acc, cur, wr, wc, fr, fq); S.done(cur); }
        PG8_STAMP();
        if (!has_next) break;
#pragma unroll
        for (int a = 0; a < 2; ++a)
#pragma unroll
            for (int b = 0; b < 2; ++b)
#pragma unroll
                for (int m = 0; m < 4; ++m)
#pragma unroll
                    for (int n = 0; n < 2; ++n) acc[a][b][m][n] = (f32x4){0.f, 0.f, 0.f, 0.f};
        cur = nxt; cA = nA; cB = nB; ++ui;
    }
    PG8_WAIT_V(0);
    if (wr == 0) PG8_BAR;
    PG8_BAR;
    if constexpr (Epi::AFTER_DRAIN) { E.fused(acc, cur, wr, wc, fr, fq, lds, wid, lane); S.done(cur); }
    PG8_STAMP();
#undef PG8_STAMP
#undef PG8_SA
#undef PG8_SB
#undef PG8_STAGE
#undef PG8_LDA
#undef PG8_LDB
#undef PG8_MMA
#undef PG8_WAIT_V
#undef PG8_WAIT_L
#undef PG8_BAR
#undef PG8_SCHED
}
}


using pg8::bf16_t; using pg8::bf16x8; using pg8::f32x4; using pg8::u32x4;
typedef unsigned u32x2 __attribute__((ext_vector_type(2)));
#define LAS __attribute__((address_space(3)))

constexpr int D = 1024, MP = 65536, MSAMP = 512, MT = MP + MSAMP, DFF = 4096;
constexpr int LDS_BYTES = 147472, LDS_BARW = 147456;
constexpr float EPS = 1e-6f;
constexpr size_t WS_WIN = 0, WS_WOUT = WS_WIN + 16777216, WS_WUP = WS_WOUT + 8388608, WS_WDOWN = WS_WUP + 33554432, WS_WPOOL = WS_WDOWN + 33554432,
                 WS_MOD = WS_WPOOL + 1048576, WS_VSS = WS_MOD + 2359296, WS_H = WS_VSS + 8454144, WS_MIX = WS_H + 135266304, WS_Z = WS_MIX + 135266304, WS_X16 = WS_Z + 541065216, WS_BAR = WS_X16 + 135266304, WS_CEN = WS_BAR + 16384, WS_END = WS_CEN + 4096;
constexpr size_t OUT_YS = 67108864, OUT_SPP = 67633152, OUT_SSS = 67878912, OUT_SPS = 69976064;

struct Params { const float* in[17]; float* out; unsigned char* ws; };

__device__ __forceinline__ float bf_lo(unsigned w) { return __uint_as_float(w << 16); }
__device__ __forceinline__ float bf_hi(unsigned w) { return __uint_as_float(w & 0xffff0000u); }
__device__ __forceinline__ void unpack8(const u32x4 w, float (&f)[8]) {
    f[0] = bf_lo(w.x); f[1] = bf_hi(w.x); f[2] = bf_lo(w.y); f[3] = bf_hi(w.y); f[4] = bf_lo(w.z); f[5] = bf_hi(w.z); f[6] = bf_lo(w.w); f[7] = bf_hi(w.w); }
__device__ __forceinline__ u32x4 pack8(const float (&f)[8]) {
    u32x4 w; w.x = pg8::cvt_pk_bf16(f[0], f[1]); w.y = pg8::cvt_pk_bf16(f[2], f[3]); w.z = pg8::cvt_pk_bf16(f[4], f[5]); w.w = pg8::cvt_pk_bf16(f[6], f[7]); return w; }
__device__ __forceinline__ int opaque_tid() { int t = threadIdx.x; asm volatile("" : "+v"(t)); return t; }
__device__ __forceinline__ float wave_sum(float v) {
#pragma unroll
    for (int o = 32; o >= 1; o >>= 1) v += __shfl_xor(v, o);
    return v; }
typedef float f32x2 __attribute__((ext_vector_type(2)));
__device__ __forceinline__ f32x2 gelu2(f32x2 x) {
    const f32x2 t = x * (x * x * (-0.1029432371f) + (-2.3022081982f));
    f32x2 e; e[0] = __builtin_amdgcn_exp2f(t[0]); e[1] = __builtin_amdgcn_exp2f(t[1]);
    const f32x2 d = e + 1.0f;
    f32x2 r; r[0] = __builtin_amdgcn_rcpf(d[0]); r[1] = __builtin_amdgcn_rcpf(d[1]);
    return x * r; }
__device__ __forceinline__ float relu1(float x) { float r; asm("v_max_f32 %0, 0, %1" : "=v"(r) : "v"(x)); return r; }
__device__ __forceinline__ float gelu_tanh(float x) {
    const float y = x * (1.5957691216f + 0.0713548163f * x * x);
    const float e = __builtin_amdgcn_exp2f(-1.4426950409f * y);
    return x * __builtin_amdgcn_rcpf(1.0f + e); }

template <int ACT> struct EpiAct {
    static constexpr bool PERM = true, AFTER_DRAIN = false;
    bf16_t* O; int ldc; float* vss; const float* scale;
    __device__ __forceinline__ void operator()(const f32x4 (&acc)[2][2][4][2], const pg8::Unit& u, int wr, int wc, int fr, int fq) const {
        const int row0 = u.pm * 256 + wr * 64 + fr, col0 = u.pn * 256 + wc * 32 + 8 * fq;
        f32x4 sv[2][2];
#pragma unroll
        for (int bj = 0; bj < 2; ++bj)
#pragma unroll
            for (int n = 0; n < 2; ++n) sv[bj][n] = (ACT == 2 && scale) ? *(const f32x4*)(scale + col0 + bj * 128 + 4 * n) : (f32x4){1.f, 1.f, 1.f, 1.f};
#pragma unroll
        for (int ai = 0; ai < 2; ++ai)
#pragma unroll
            for (int m = 0; m < 4; ++m) {
                const int row = row0 + ai * 128 + m * 16;
                bf16_t* rowp = O + (size_t)row * ldc + col0;
                float ss = 0.f;
#pragma unroll
                for (int bj = 0; bj < 2; ++bj) {
                    f32x4 v0 = acc[ai][bj][m][0], v1 = acc[ai][bj][m][1];
                    if (ACT == 0) {
                        const f32x2 a = gelu2((f32x2){v0[0], v0[1]}), b = gelu2((f32x2){v0[2], v0[3]}), c = gelu2((f32x2){v1[0], v1[1]}), d = gelu2((f32x2){v1[2], v1[3]});
                        v0 = (f32x4){a[0], a[1], b[0], b[1]}; v1 = (f32x4){c[0], c[1], d[0], d[1]};
                        if (u.pn >= 8) { const f32x2 q = a * a + b * b + c * c + d * d; ss += q[0] + q[1]; }
                    }
                    if (ACT == 1) {
#pragma unroll
                        for (int j = 0; j < 4; ++j) { const float a = relu1(v0[j]), b = relu1(v1[j]); v0[j] = a * a; v1[j] = b * b; }
                    }
                    if (ACT == 2) { v0 *= sv[bj][0]; v1 *= sv[bj][1]; }
                    u32x4 w; w.x = pg8::cvt_pk_bf16(v0[0], v0[1]); w.y = pg8::cvt_pk_bf16(v0[2], v0[3]); w.z = pg8::cvt_pk_bf16(v1[0], v1[1]); w.w = pg8::cvt_pk_bf16(v1[2], v1[3]);
                    if (ACT != 1) *(u32x4*)(rowp + bj * 128) = w; else __builtin_nontemporal_store(w, (u32x4*)(rowp + bj * 128));
                }
                if (ACT == 0) {
                    if (u.pn >= 8) { ss += __shfl_xor(ss, 16); ss += __shfl_xor(ss, 32); if (fq == 0) vss[(size_t)row * 32 + (u.pn - 8) * 4 + wc] = ss; }
                }
            }
    }
};

template <int ACT>
__device__ __forceinline__ void sgemm_wide(const bf16_t* A, const bf16_t* Bt, bf16_t* O) {
    const int tid = opaque_tid(), lane = tid & 63, wv = tid >> 6, fr = lane & 15, fq = lane >> 4, wr = wv >> 2, wc = wv & 3;
    for (int t = blockIdx.x; t < 256; t += gridDim.x) {
        const int row0 = MP + (t >> 5) * 64 + wr * 32, col0 = (t & 31) * 128 + wc * 32;
        const bf16_t* ap = A + (size_t)(row0 + fr) * 1024 + 8 * fq;
        const bf16_t* bp = Bt + (size_t)(col0 + fr) * 1024 + 8 * fq;
        f32x4 acc[2][2];
#pragma unroll
        for (int mi = 0; mi < 2; ++mi) { acc[mi][0] = (f32x4){0.f, 0.f, 0.f, 0.f}; acc[mi][1] = acc[mi][0]; }
#pragma unroll 8
        for (int ks = 0; ks < 1024; ks += 32) {
            bf16x8 a[2], b[2];
#pragma unroll
            for (int i = 0; i < 2; ++i) { a[i] = *(const bf16x8*)(ap + (size_t)(16 * i) * 1024 + ks); b[i] = *(const bf16x8*)(bp + (size_t)(16 * i) * 1024 + ks); }
#pragma unroll
            for (int mi = 0; mi < 2; ++mi)
#pragma unroll
                for (int ni = 0; ni < 2; ++ni) acc[mi][ni] = __builtin_amdgcn_mfma_f32_16x16x32_bf16(b[ni], a[mi], acc[mi][ni], 0, 0, 0);
        }
#pragma unroll
        for (int mi = 0; mi < 2; ++mi)
#pragma unroll
            for (int ni = 0; ni < 2; ++ni) {
                f32x4 s = acc[mi][ni];
                if (ACT == 0) { const f32x2 p = gelu2((f32x2){s[0], s[1]}), q = gelu2((f32x2){s[2], s[3]}); s = (f32x4){p[0], p[1], q[0], q[1]}; }
                if (ACT == 1) {
#pragma unroll
                    for (int j = 0; j < 4; ++j) { const float v = fmaxf(s[j], 0.f); s[j] = v * v; }
                }
                u32x2 w; w.x = pg8::cvt_pk_bf16(s[0], s[1]); w.y = pg8::cvt_pk_bf16(s[2], s[3]);
                *(u32x2*)(O + (size_t)(row0 + 16 * mi + fr) * 4096 + col0 + 16 * ni + 4 * fq) = w;
            }
    }
}

template <int ACT>
__device__ __forceinline__ void sgemm_phase(LAS float* red, const bf16_t* A, int lda, int acol, const bf16_t* Bt, int N, int K, bf16_t* O, int ldc, const float* scale) {
    const int tid = opaque_tid(), lane = tid & 63, wv = tid >> 6, fr = lane & 15, fq = lane >> 4;
    const int ntn = N >> 5, ntiles = 8 * ntn, kw = K >> 3;
    for (int t = blockIdx.x; t < ntiles; t += gridDim.x) {
        const int tm = t / ntn, tn = t - tm * ntn, row0 = MP + tm * 64, col0 = tn * 32;
        const bf16_t* ap = A + (size_t)(row0 + fr) * lda + (col0 >> 8) * acol + wv * kw + 8 * fq;
        const bf16_t* bp = Bt + (size_t)(col0 + fr) * K + wv * kw + 8 * fq;
        f32x4 acc[4][2];
#pragma unroll
        for (int mi = 0; mi < 4; ++mi) { acc[mi][0] = (f32x4){0.f, 0.f, 0.f, 0.f}; acc[mi][1] = acc[mi][0]; }
#pragma unroll 4
        for (int ks = 0; ks < kw; ks += 32) {
            bf16x8 a[4], b[2];
#pragma unroll
            for (int mi = 0; mi < 4; ++mi) a[mi] = *(const bf16x8*)(ap + (size_t)(16 * mi) * lda + ks);
#pragma unroll
            for (int ni = 0; ni < 2; ++ni) b[ni] = *(const bf16x8*)(bp + (size_t)(16 * ni) * K + ks);
#pragma unroll
            for (int mi = 0; mi < 4; ++mi)
#pragma unroll
                for (int ni = 0; ni < 2; ++ni) acc[mi][ni] = __builtin_amdgcn_mfma_f32_16x16x32_bf16(b[ni], a[mi], acc[mi][ni], 0, 0, 0);
        }
#pragma unroll
        for (int mi = 0; mi < 4; ++mi)
#pragma unroll
            for (int ni = 0; ni < 2; ++ni) *(LAS f32x4*)(red + ((wv * 64 + 16 * mi + fr) * 36 + 16 * ni + 4 * fq)) = acc[mi][ni];
        __syncthreads();
        {
            const int row = tid >> 3, c4 = (tid & 7) * 4;
            f32x4 s = (f32x4){0.f, 0.f, 0.f, 0.f};
#pragma unroll
            for (int w8 = 0; w8 < 8; ++w8) s += *(const LAS f32x4*)(red + ((w8 * 64 + row) * 36 + c4));
            if (ACT == 0) {
#pragma unroll
                for (int j = 0; j < 4; ++j) s[j] = gelu_tanh(s[j]);
            }
            if (ACT == 1) {
#pragma unroll
                for (int j = 0; j < 4; ++j) { const float a = fmaxf(s[j], 0.f); s[j] = a * a; }
            }
            if (ACT == 2) { if (scale) s *= *(const f32x4*)(scale + col0 + c4); }
            u32x2 w; w.x = pg8::cvt_pk_bf16(s[0], s[1]); w.y = pg8::cvt_pk_bf16(s[2], s[3]);
            *(u32x2*)(O + (size_t)(row0 + row) * ldc + col0 + c4) = w;
        }
        __syncthreads();
    }
}

__device__ __forceinline__ void mod_phase(const Params& P, LAS float* lds) {
    LAS float* sc = lds; LAS float* red = lds + 24576;
    const int tid = opaque_tid(), lane = tid & 63, wv = tid >> 6;
    for (int i = tid; i < 24576; i += 512) { const int b = i >> 10, k = i & 1023; const float c = b < 8 ? P.in[3][b * 1024 + k] : P.in[4][(b - 8) * 1024 + k]; sc[k * 24 + b] = c / (1.0f + __expf(-c)); }
    __syncthreads();
    float* modo = (float*)(P.ws + WS_MOD);
    for (int task = blockIdx.x; task < 768; task += gridDim.x) {
        const int l = task / 192, n0 = (task % 192) * 32, cl = lane & 31, ksl = wv * 2 + (lane >> 5);
        const float* w = P.in[6] + (size_t)l * 1024 * 6144 + n0 + cl;
        float acc[24];
#pragma unroll
        for (int b = 0; b < 24; ++b) acc[b] = 0.f;
        const int k0 = ksl * 64;
#pragma unroll 16
        for (int k = k0; k < k0 + 64; ++k) {
            const float wk = w[(size_t)k * 6144];
            const LAS f32x4* s4 = (const LAS f32x4*)(sc + k * 24);
#pragma unroll
            for (int q = 0; q < 6; ++q) { const f32x4 s = s4[q]; acc[4 * q + 0] += wk * s[0]; acc[4 * q + 1] += wk * s[1]; acc[4 * q + 2] += wk * s[2]; acc[4 * q + 3] += wk * s[3]; }
        }
#pragma unroll
        for (int b = 0; b < 24; ++b) red[(ksl * 24 + b) * 32 + cl] = acc[b];
        __syncthreads();
        for (int o = tid; o < 768; o += 512) {
            const int b = o >> 5, n = o & 31; float s = 0.f;
#pragma unroll
            for (int w16 = 0; w16 < 16; ++w16) s += red[(w16 * 24 + b) * 32 + n];
            modo[(size_t)(l * 24 + b) * 6144 + n0 + n] = s + P.in[7][l * 6144 + n0 + n];
        }
        __syncthreads();
    }
}

__device__ __forceinline__ void convert_phase(const Params& P, LAS float* lds) {
    const int tid = opaque_tid(), lane = tid & 63, wv = tid >> 6;
    LAS float* tile = lds + wv * 4160;
    for (int t = blockIdx.x * 8 + wv; t < 11392; t += gridDim.x * 8) {
        const float* src; bf16_t* dst; int K, N, loc;
        if (t < 2048)       { src = P.in[8];  dst = (bf16_t*)(P.ws + WS_WIN);   K = 1024; N = 4096; loc = t; }
        else if (t < 3072)  { src = P.in[12]; dst = (bf16_t*)(P.ws + WS_WOUT);  K = 2048; N = 1024; loc = t - 2048; }
        else if (t < 7168)  { src = P.in[15]; dst = (bf16_t*)(P.ws + WS_WUP);   K = 1024; N = 4096; loc = t - 3072; }
        else if (t < 11264) { src = P.in[16]; dst = (bf16_t*)(P.ws + WS_WDOWN); K = 4096; N = 1024; loc = t - 7168; }
        else                { src = P.in[13]; dst = (bf16_t*)(P.ws + WS_WPOOL); K = 256;  N = 256;  loc = t - 11264; }
        const int tn = N >> 6, per = (K >> 6) * tn, mat = loc / per, rem = loc - mat * per, kt = rem / tn, ntile = rem - kt * tn;
        const float* s = src + (size_t)mat * K * N + (size_t)(kt * 64) * N + ntile * 64;
        bf16_t* d = dst + (size_t)mat * K * N + (size_t)(ntile * 64) * K + kt * 64;
        f32x4 v[16];
#pragma unroll
        for (int it = 0; it < 16; ++it) { const int idx = lane + 64 * it, kr = idx >> 4, c4 = (idx & 15) * 4; v[it] = *(const f32x4*)(s + (size_t)kr * N + c4); }
#pragma unroll
        for (int it = 0; it < 16; ++it) { const int idx = lane + 64 * it, kr = idx >> 4, c4 = (idx & 15) * 4;
            tile[kr * 65 + c4 + 0] = v[it][0]; tile[kr * 65 + c4 + 1] = v[it][1]; tile[kr * 65 + c4 + 2] = v[it][2]; tile[kr * 65 + c4 + 3] = v[it][3]; }
        asm volatile("s_waitcnt lgkmcnt(0)" ::: "memory");
#pragma unroll
        for (int it = 0; it < 8; ++it) {
            const int idx = lane + 64 * it, n = idx >> 3, kc = idx & 7; float f[8];
#pragma unroll
            for (int e = 0; e < 8; ++e) f[e] = tile[(8 * kc + e) * 65 + n];
            *(u32x4*)(d + (size_t)n * K + 8 * kc) = pack8(f);
        }
        asm volatile("s_waitcnt lgkmcnt(0)" ::: "memory");
    }
    __syncthreads();
}

typedef _Float16 f16x8 __attribute__((ext_vector_type(8)));
__device__ __forceinline__ void unpack8h(const u32x4 w, float (&f)[8]) { const f16x8 h = __builtin_bit_cast(f16x8, w);
#pragma unroll
    for (int e = 0; e < 8; ++e) f[e] = (float)h[e]; }
__device__ __forceinline__ u32x4 pack8h(const float (&f)[8]) { f16x8 h;
#pragma unroll
    for (int e = 0; e < 8; ++e) h[e] = (_Float16)f[e];
    return __builtin_bit_cast(u32x4, h); }
struct RnCfg { bool has_h, wstate, final_; int jl; };
struct RnRow { u32x4 xh[2], mw[2]; };
__device__ __forceinline__ void rn_load(const Params& P, int row, int lane, RnRow& R) {
    const bf16_t* x16 = (const bf16_t*)(P.ws + WS_X16); const bf16_t* mix = (const bf16_t*)(P.ws + WS_MIX);
#pragma unroll
    for (int hh = 0; hh < 2; ++hh) { R.xh[hh] = __builtin_nontemporal_load((const u32x4*)(x16 + (size_t)row * 1024 + hh * 512 + 8 * lane)); R.mw[hh] = __builtin_nontemporal_load((const u32x4*)(mix + (size_t)row * 1024 + hh * 512 + 8 * lane)); }
}
__device__ __forceinline__ void rn_emit_h(const Params& P, const RnCfg& c, int row, int b, int lane, const float (&ca)[2][8], const float (&cs)[2][8], const float (&x)[2][8]) {
    bf16_t* hbuf = (bf16_t*)(P.ws + WS_H);
    float ss = 0.f;
#pragma unroll
    for (int hh = 0; hh < 2; ++hh)
#pragma unroll
        for (int e = 0; e < 8; ++e) ss += x[hh][e] * x[hh][e];
    ss = wave_sum(ss);
    const float r2 = rsqrtf(ss * (1.0f / 1024.0f) + EPS);
    float hv[2][8];
#pragma unroll
    for (int hh = 0; hh < 2; ++hh) {
#pragma unroll
        for (int e = 0; e < 8; ++e) hv[hh][e] = x[hh][e] * r2 * ca[hh][e] + cs[hh][e];
        *(u32x4*)(hbuf + (size_t)row * 1024 + hh * 512 + 8 * lane) = pack8(hv[hh]);
    }
    if (c.wstate) {
        float* dst = nullptr;
        if (row < MP) { const int rr = row & 8191; if (rr >= 8177) dst = P.out + OUT_SPP + ((size_t)(c.jl * 8 + b) * 15 + (rr - 8177)) * 1024; }
        else { const int rr = (row - MP) & 31; if (rr >= 17) dst = P.out + OUT_SPS + ((size_t)(c.jl * 16 + (b - 8)) * 15 + (rr - 17)) * 1024; }
        if (dst) {
#pragma unroll
            for (int hh = 0; hh < 2; ++hh) { *(f32x4*)(dst + hh * 512 + 8 * lane) = (f32x4){hv[hh][0], hv[hh][1], hv[hh][2], hv[hh][3]}; *(f32x4*)(dst + hh * 512 + 8 * lane + 4) = (f32x4){hv[hh][4], hv[hh][5], hv[hh][6], hv[hh][7]}; }
        }
    }
}
__device__ __forceinline__ void rn_process(const Params& P, const RnCfg& c, int row, int b, int lane, const float (&cg)[2][8], const float (&ca)[2][8], const float (&cs)[2][8], const RnRow& R) {
    float x[2][8], m[2][8]; float ss = 0.f;
#pragma unroll
    for (int hh = 0; hh < 2; ++hh) { unpack8h(R.xh[hh], x[hh]); unpack8(R.mw[hh], m[hh]);
#pragma unroll
        for (int e = 0; e < 8; ++e) ss += m[hh][e] * m[hh][e]; }
    ss = wave_sum(ss);
    const float r1 = rsqrtf(ss * (1.0f / 1024.0f) + EPS);
#pragma unroll
    for (int hh = 0; hh < 2; ++hh)
#pragma unroll
        for (int e = 0; e < 8; ++e) x[hh][e] += m[hh][e] * r1 * cg[hh][e];
    if (c.final_) {
#pragma unroll
        for (int hh = 0; hh < 2; ++hh) { float* dst = P.out + (size_t)row * 1024 + hh * 512 + 8 * lane;
            *(f32x4*)dst = (f32x4){x[hh][0], x[hh][1], x[hh][2], x[hh][3]}; *(f32x4*)(dst + 4) = (f32x4){x[hh][4], x[hh][5], x[hh][6], x[hh][7]}; }
    } else {
        bf16_t* x16 = (bf16_t*)(P.ws + WS_X16);
#pragma unroll
        for (int hh = 0; hh < 2; ++hh) __builtin_nontemporal_store(pack8h(x[hh]), (u32x4*)(x16 + (size_t)row * 1024 + hh * 512 + 8 * lane));
    }
    if (c.has_h) rn_emit_h(P, c, row, b, lane, ca, cs, x);
}
__device__ __forceinline__ void rn_vectors(const Params& P, int li, int ln, int mode, int b, int lane, bool has_mix, bool has_h, float (&cg)[2][8], float (&ca)[2][8], float (&cs)[2][8]) {
    const float* modb = (const float*)(P.ws + WS_MOD); const float* gn = P.in[5];
    const int g_res_idx = li * 4 + (mode == 1 ? 1 : 3), gate_chunk = mode == 1 ? 2 : 5;
    const int g2_idx = ln * 4 + (mode == 1 ? 2 : 0), sc_chunk = mode == 1 ? 4 : 1, sh_chunk = mode == 1 ? 3 : 0;
#pragma unroll
    for (int hh = 0; hh < 2; ++hh)
#pragma unroll
        for (int q = 0; q < 2; ++q) {
            const int col = hh * 512 + 8 * lane + 4 * q;
            f32x4 vg = (f32x4){0.f, 0.f, 0.f, 0.f}, va = vg, vs = vg;
            if (has_mix) vg = *(const f32x4*)(modb + ((size_t)(li * 24 + b) * 6 + gate_chunk) * 1024 + col) * *(const f32x4*)(gn + g_res_idx * 1024 + col);
            if (has_h) { va = *(const f32x4*)(gn + g2_idx * 1024 + col) * (*(const f32x4*)(modb + ((size_t)(ln * 24 + b) * 6 + sc_chunk) * 1024 + col) + 1.0f);
                         vs = *(const f32x4*)(modb + ((size_t)(ln * 24 + b) * 6 + sh_chunk) * 1024 + col); }
#pragma unroll
            for (int e = 0; e < 4; ++e) { cg[hh][4 * q + e] = vg[e]; ca[hh][4 * q + e] = va[e]; cs[hh][4 * q + e] = vs[e]; }
        }
}
__device__ __forceinline__ void resnorm_phase(const Params& P, int li, int mode, int first_task) {
    const int tid = opaque_tid(), lane = tid & 63, wv = tid >> 6;
    RnCfg c;
    c.has_h = !(mode == 2 && li == 3); c.final_ = (mode == 2 && li == 3);
    const int ln = mode == 2 ? li + 1 : li;
    c.wstate = c.has_h && mode != 1 && (ln & 1);
    c.jl = ln >> 1;
    for (int sr = blockIdx.x * 8 + wv; sr < MSAMP; sr += gridDim.x * 8) {
        const int row = MP + sr, b = 8 + (sr >> 5);
        float cg[2][8], ca[2][8], cs[2][8];
        rn_vectors(P, li, ln, mode, b, lane, mode != 0, c.has_h, cg, ca, cs);
        if (mode == 0) {
            bf16_t* x16 = (bf16_t*)(P.ws + WS_X16);
            const float* xs = P.in[1] + (size_t)sr * 1024;
            float x[2][8];
#pragma unroll
            for (int hh = 0; hh < 2; ++hh) { const f32x4 a = __builtin_nontemporal_load((const f32x4*)(xs + hh * 512 + 8 * lane)), bq = __builtin_nontemporal_load((const f32x4*)(xs + hh * 512 + 8 * lane + 4));
                x[hh][0] = a[0]; x[hh][1] = a[1]; x[hh][2] = a[2]; x[hh][3] = a[3]; x[hh][4] = bq[0]; x[hh][5] = bq[1]; x[hh][6] = bq[2]; x[hh][7] = bq[3];
                __builtin_nontemporal_store(pack8h(x[hh]), (u32x4*)(x16 + (size_t)row * 1024 + hh * 512 + 8 * lane)); }
            rn_emit_h(P, c, row, b, lane, ca, cs, x);
        } else { RnRow R; rn_load(P, row, lane, R); rn_process(P, c, row, b, lane, cg, ca, cs, R); }
    }
    for (int t = first_task + blockIdx.x * 8 + wv; t < 2048; t += gridDim.x * 8) {
        const int row0 = t * 32, b = t >> 8;
        float cg[2][8], ca[2][8], cs[2][8];
        rn_vectors(P, li, ln, mode, b, lane, mode != 0, c.has_h, cg, ca, cs);
        if (mode == 0) {
            bf16_t* x16 = (bf16_t*)(P.ws + WS_X16);
#pragma unroll 2
            for (int r = 0; r < 32; ++r) {
                const int row = row0 + r;
                const float* xs = P.in[0] + (size_t)row * 1024;
                float x[2][8];
#pragma unroll
                for (int hh = 0; hh < 2; ++hh) { const f32x4 a = __builtin_nontemporal_load((const f32x4*)(xs + hh * 512 + 8 * lane)), bq = __builtin_nontemporal_load((const f32x4*)(xs + hh * 512 + 8 * lane + 4));
                    x[hh][0] = a[0]; x[hh][1] = a[1]; x[hh][2] = a[2]; x[hh][3] = a[3]; x[hh][4] = bq[0]; x[hh][5] = bq[1]; x[hh][6] = bq[2]; x[hh][7] = bq[3];
                    __builtin_nontemporal_store(pack8h(x[hh]), (u32x4*)(x16 + (size_t)row * 1024 + hh * 512 + 8 * lane)); }
                rn_emit_h(P, c, row, b, lane, ca, cs, x);
            }
        } else {
            RnRow R0, R1, R2, R3;
            rn_load(P, row0, lane, R0); rn_load(P, row0 + 1, lane, R1); rn_load(P, row0 + 2, lane, R2);
#pragma unroll 1
            for (int r = 0; r < 32; r += 4) {
                rn_load(P, row0 + r + 3, lane, R3);
                rn_process(P, c, row0 + r, b, lane, cg, ca, cs, R0);
                if (r + 4 < 32) rn_load(P, row0 + r + 4, lane, R0);
                rn_process(P, c, row0 + r + 1, b, lane, cg, ca, cs, R1);
                if (r + 4 < 32) rn_load(P, row0 + r + 5, lane, R1);
                rn_process(P, c, row0 + r + 2, b, lane, cg, ca, cs, R2);
                if (r + 4 < 32) rn_load(P, row0 + r + 6, lane, R2);
                rn_process(P, c, row0 + r + 3, b, lane, cg, ca, cs, R3);
            }
        }
    }
}

__device__ __forceinline__ void pool_phase(const Params& P, int jl) {
    const int tid = opaque_tid(), lane = tid & 63, wv = tid >> 6;
    const bf16_t* h = (const bf16_t*)(P.ws + WS_H); bf16_t* pooled = (bf16_t*)(P.ws + WS_Z);
    for (int task = blockIdx.x * 8 + wv; task < 2048 + 128; task += gridDim.x * 8) {
        if (task < 2048) {
            const int half = task & 1, row0 = (task >> 1) * 64, pos0 = row0 & 8191;
            const int col = half * 512 + lane * 8, w = 2 << (col >> 8);
            const bf16_t* hp = h + (size_t)row0 * 1024 + col;
            bf16_t* op = pooled + (size_t)row0 * 1024 + col;
            float s[8];
#pragma unroll
            for (int e = 0; e < 8; ++e) s[e] = 0.f;
            if (pos0 > 0) {
#pragma unroll
                for (int k = 1; k < 16; ++k) { float f[8]; unpack8(*(const u32x4*)(hp - (ptrdiff_t)k * 1024), f); const float m = k < w ? 1.f : 0.f;
#pragma unroll
                    for (int e = 0; e < 8; ++e) s[e] += m * f[e]; }
            }
            const float inv_w = 1.0f / (float)w;
            const int lo = pos0 > 0 ? -15 : 0;
#pragma unroll 8
            for (int r = 0; r < 64; ++r) {
                float c[8], f[8]; unpack8(*(const u32x4*)(hp + (size_t)r * 1024), c);
                const int ro = r - w + 1, rc = ro > lo ? ro : lo;
                unpack8(*(const u32x4*)(hp + (ptrdiff_t)rc * 1024), f);
                const float m = ro >= lo ? 1.f : 0.f;
                const int p = pos0 + r;
                const float inv = (p + 1 >= w) ? inv_w : 1.0f / (float)(p + 1);
                float o[8];
#pragma unroll
                for (int e = 0; e < 8; ++e) { s[e] += c[e]; o[e] = s[e] * inv - c[e]; s[e] -= m * f[e]; }
                *(u32x4*)(op + (size_t)r * 1024) = pack8(o);
            }
        } else {
            const int k = task - 2048, seq = k >> 3, half = (k >> 2) & 1, pos0 = (k & 3) * 8;
            const int col = half * 512 + lane * 8, w = 2 << (col >> 8);
            const float* cache = P.in[2] + (size_t)((jl * 16 + seq) * 15) * 1024 + col;
            const bf16_t* hp = h + (size_t)(MP + seq * 32) * 1024 + col;
            bf16_t* op = pooled + (size_t)(MP + seq * 32) * 1024 + col;
            float s[8];
#pragma unroll
            for (int e = 0; e < 8; ++e) s[e] = 0.f;
#pragma unroll
            for (int kk = 1; kk < 16; ++kk) {
                const int p = pos0 - kk; float f[8];
                if (p >= 0) unpack8(*(const u32x4*)(hp + (size_t)p * 1024), f);
                else { const f32x4 a = *(const f32x4*)(cache + (15 + p) * 1024), c = *(const f32x4*)(cache + (15 + p) * 1024 + 4); f[0] = a[0]; f[1] = a[1]; f[2] = a[2]; f[3] = a[3]; f[4] = c[0]; f[5] = c[1]; f[6] = c[2]; f[7] = c[3]; }
                const float m = kk < w ? 1.f : 0.f;
#pragma unroll
                for (int e = 0; e < 8; ++e) s[e] += m * f[e];
            }
            const float inv_w = 1.0f / (float)w;
#pragma unroll
            for (int r = 0; r < 8; ++r) {
                const int p = pos0 + r;
                float c[8], f[8]; unpack8(*(const u32x4*)(hp + (size_t)p * 1024), c);
                const int po = p - w + 1, pc = po > 0 ? po : 0, ci = po < 0 ? 15 + po : 0;
                unpack8(*(const u32x4*)(hp + (size_t)pc * 1024), f);
                const f32x4 ca = *(const f32x4*)(cache + ci * 1024), cb = *(const f32x4*)(cache + ci * 1024 + 4);
                if (po < 0) { f[0] = ca[0]; f[1] = ca[1]; f[2] = ca[2]; f[3] = ca[3]; f[4] = cb[0]; f[5] = cb[1]; f[6] = cb[2]; f[7] = cb[3]; }
                float o[8];
#pragma unroll
                for (int e = 0; e < 8; ++e) { s[e] += c[e]; o[e] = s[e] * inv_w - c[e]; s[e] -= f[e]; }
                *(u32x4*)(op + (size_t)p * 1024) = pack8(o);
            }
        }
    }
}

__device__ __forceinline__ unsigned off_b(unsigned row, unsigned ch) { return 256u * row + 16u * (ch ^ (((row & 3) << 2) | ((row >> 2) & 3))); }
__device__ __forceinline__ unsigned tr_addr16(unsigned lane, unsigned c, unsigned ks, unsigned t) {
    const unsigned g = lane >> 4, q = (lane & 15) >> 2, p = lane & 3;
    return off_b(32 * ks + 8 * g + 4 * t + q, 2 * c + (p >> 1)) + 8 * (p & 1);
}
__device__ __forceinline__ bf16x8 tr_read_pair(unsigned a0, unsigned a1) {
    u32x2 lo, hi;
    asm volatile("ds_read_b64_tr_b16 %0, %2\n\tds_read_b64_tr_b16 %1, %3\n\ts_waitcnt lgkmcnt(0)" : "=&v"(lo), "=&v"(hi) : "v"(a0), "v"(a1) : "memory");
    u32x4 w; w.x = lo.x; w.y = lo.y; w.z = hi.x; w.w = hi.y;
    return __builtin_bit_cast(bf16x8, w);
}

template <bool SAMP>
__device__ __forceinline__ void gate_unit(const LAS unsigned char* wl, const float (&bsl)[8], bf16_t* z, int r0, int g, unsigned img, int lane, int wv) {
    constexpr int NIH = SAMP ? 1 : 2, NI = SAMP ? 2 : 4, NKS = SAMP ? 1 : 4;
    const int fr = lane & 15, fq = lane >> 4, half = wv >> 2;
#pragma unroll
    for (int n = 0; n < 2; ++n) {
        const unsigned c = 2 * (wv & 3) + n;
        bf16_t* ubase = z + (size_t)(r0 + fr) * 4096 + g * 256 + half * 128 + 16 * c + 4 * fq;
        u32x2 uw[NIH * NI];
#pragma unroll
        for (int it = 0; it < NIH * NI; ++it) uw[it] = *(const u32x2*)(ubase + (size_t)(16 * it) * 4096);
        bf16x8 vf[NKS];
        if (SAMP) vf[0] = tr_read_pair(img + half * 32768 + tr_addr16(lane, c, 0, 0), img + half * 32768 + tr_addr16(lane, c, 0, 1));
        else {
            u32x2 q[8]; unsigned ad[8];
#pragma unroll
            for (int i = 0; i < 8; ++i) ad[i] = img + half * 32768 + tr_addr16(lane, c, i >> 1, i & 1);
            asm volatile("ds_read_b64_tr_b16 %0, %8\n\tds_read_b64_tr_b16 %1, %9\n\tds_read_b64_tr_b16 %2, %10\n\tds_read_b64_tr_b16 %3, %11\n\t"
                         "ds_read_b64_tr_b16 %4, %12\n\tds_read_b64_tr_b16 %5, %13\n\tds_read_b64_tr_b16 %6, %14\n\tds_read_b64_tr_b16 %7, %15\n\ts_waitcnt lgkmcnt(0)"
                         : "=&v"(q[0]), "=&v"(q[1]), "=&v"(q[2]), "=&v"(q[3]), "=&v"(q[4]), "=&v"(q[5]), "=&v"(q[6]), "=&v"(q[7])
                         : "v"(ad[0]), "v"(ad[1]), "v"(ad[2]), "v"(ad[3]), "v"(ad[4]), "v"(ad[5]), "v"(ad[6]), "v"(ad[7]) : "memory");
#pragma unroll
            for (int ks = 0; ks < NKS; ++ks) { u32x4 w; w.x = q[2 * ks].x; w.y = q[2 * ks].y; w.z = q[2 * ks + 1].x; w.w = q[2 * ks + 1].y; vf[ks] = __builtin_bit_cast(bf16x8, w); }
        }
#pragma unroll
        for (int ih = 0; ih < NIH; ++ih) {
            f32x4 acc[NI];
#pragma unroll
            for (int ii = 0; ii < NI; ++ii) acc[ii] = (f32x4){0.f, 0.f, 0.f, 0.f};
#pragma unroll
            for (int ii = 0; ii < NI; ++ii)
#pragma unroll
                for (int ks = 0; ks < NKS; ++ks)
                    if (SAMP || ks < 2 || ih == 1) acc[ii] = __builtin_amdgcn_mfma_f32_16x16x32_bf16(vf[ks], *(const LAS bf16x8*)(wl + (16 * (ih * 4 + ii) + fr) * 272 + (32 * ks + 8 * fq) * 2), acc[ii], 0, 0, 0);
#pragma unroll
            for (int ii = 0; ii < NI; ++ii) {
                const int it = ih * 4 + ii;
                const f32x4 a = acc[ii] + bsl[it];
                u32x2 ow; ow.x = pg8::cvt_pk_bf16(bf_lo(uw[it].x) * a[0], bf_hi(uw[it].x) * a[1]); ow.y = pg8::cvt_pk_bf16(bf_lo(uw[it].y) * a[2], bf_hi(uw[it].y) * a[3]);
                *(u32x2*)(ubase + (size_t)(16 * it) * 4096) = ow;
            }
        }
    }
}

__device__ __forceinline__ void gate_phase(const Params& P, int jl, LAS unsigned char* lds) {
    const int tid = opaque_tid(), lane = tid & 63, wv = tid >> 6, fr = lane & 15, fq = lane >> 4;
    const int g = blockIdx.x & 7, cstride = gridDim.x >> 3;
    bf16_t* z = (bf16_t*)(P.ws + WS_Z);
    const float* vss = (const float*)(P.ws + WS_VSS);
    LAS float* rstd_l = (LAS float*)(lds + 65536);
    const unsigned img = (unsigned)(size_t)lds;
    LAS unsigned char* wl = lds + 66560;
    {
        const float* wsg = P.in[10] + (size_t)(jl * 8 + g) * 128 * 128 + (tid >> 2) * 128 + (tid & 3) * 32;
#pragma unroll
        for (int q = 0; q < 4; ++q) {
            const f32x4 a = *(const f32x4*)(wsg + 8 * q), b = *(const f32x4*)(wsg + 8 * q + 4);
            u32x4 w; w.x = pg8::cvt_pk_bf16(a[0], a[1]); w.y = pg8::cvt_pk_bf16(a[2], a[3]); w.z = pg8::cvt_pk_bf16(b[0], b[1]); w.w = pg8::cvt_pk_bf16(b[2], b[3]);
            *(LAS u32x4*)(wl + (tid >> 2) * 272 + ((tid & 3) * 32 + 8 * q) * 2) = w;
        }
    }
    float bsl[8];
#pragma unroll
    for (int it = 0; it < 8; ++it) bsl[it] = P.in[11][(jl * 8 + g) * 128 + 16 * it + fr];
    const int piece = tid & 31, vrow = tid >> 2, vpart = tid & 3;
    float gv[8];
    { const f32x4 a = *(const f32x4*)(P.in[9] + jl * 2048 + g * 256 + piece * 8), b = *(const f32x4*)(P.in[9] + jl * 2048 + g * 256 + piece * 8 + 4);
      gv[0] = a[0]; gv[1] = a[1]; gv[2] = a[2]; gv[3] = a[3]; gv[4] = b[0]; gv[5] = b[1]; gv[6] = b[2]; gv[7] = b[3]; }
    u32x4 vpre[8]; f32x4 spre[2];
#define GATE_PREFETCH(chn) do { const bool sp_ = (chn) >= 512; const int nit_ = sp_ ? 2 : 8, r0_ = sp_ ? MP + ((chn) - 512) * 32 : (chn) * 128; \
        _Pragma("unroll") for (int it_ = 0; it_ < 8; ++it_) if (it_ < nit_) vpre[it_] = __builtin_nontemporal_load((const u32x4*)(z + (size_t)(r0_ + ((tid + 512 * it_) >> 5)) * 4096 + 2048 + g * 256 + piece * 8)); \
        if (!sp_) { spre[0] = *(const f32x4*)(vss + (size_t)(r0_ + vrow) * 32 + vpart * 8); spre[1] = *(const f32x4*)(vss + (size_t)(r0_ + vrow) * 32 + vpart * 8 + 4); } } while (0)
    const int ch0 = blockIdx.x >> 3;
    const int nAll = ch0 < 528 ? (528 - ch0 + cstride - 1) / cstride : 0, nP = ch0 < 512 ? (512 - ch0 + cstride - 1) / cstride : 0, nOdd = nP >> 1, nEven = nP - nOdd;
#define GATE_CH(i_) (ch0 + cstride * ((i_) < nOdd ? 2 * nOdd - 1 - 2 * (i_) : ((i_) < nP ? 2 * (nEven - 1) - 2 * ((i_) - nOdd) : (i_))))
    if (nAll > 0) { const int chf = GATE_CH(0); GATE_PREFETCH(chf); }
    for (int ui = 0; ui < nAll; ++ui) {
        const int ch = GATE_CH(ui);
        const bool samp = ch >= 512; const int nit = samp ? 2 : 8, r0 = samp ? MP + (ch - 512) * 32 : ch * 128;
        if (samp) {
            const int j = tid >> 4, part = tid & 15; float ss = 0.f;
            const bf16_t* vp = z + (size_t)(r0 + j) * 4096 + 2048 + part * 128;
#pragma unroll
            for (int i = 0; i < 16; ++i) { float f[8]; unpack8(*(const u32x4*)(vp + 8 * i), f);
#pragma unroll
                for (int e = 0; e < 8; ++e) ss += f[e] * f[e]; }
            ss += __shfl_xor(ss, 1); ss += __shfl_xor(ss, 2); ss += __shfl_xor(ss, 4); ss += __shfl_xor(ss, 8);
            if (part == 0) rstd_l[j] = rsqrtf(ss * (1.0f / 2048.0f) + EPS);
        } else {
            float s = ((spre[0][0] + spre[0][1]) + (spre[0][2] + spre[0][3])) + ((spre[1][0] + spre[1][1]) + (spre[1][2] + spre[1][3]));
            s += __shfl_xor(s, 1); s += __shfl_xor(s, 2);
            if (vpart == 0) rstd_l[vrow] = rsqrtf(s * (1.0f / 2048.0f) + EPS);
        }
        __syncthreads();
#pragma unroll
        for (int it = 0; it < 8; ++it) {
            if (it < nit) {
                const int j = (tid + 512 * it) >> 5;
                float f[8]; unpack8(vpre[it], f);
                const float rs = rstd_l[j];
#pragma unroll
                for (int e = 0; e < 8; ++e) f[e] = f[e] * rs * gv[e];
                if (samp) {
                    float* dst = P.out + OUT_SSS + ((size_t)(jl * 16 + (ch - 512)) * 32 + j) * 2048 + g * 256 + piece * 8;
                    *(f32x4*)dst = (f32x4){f[0], f[1], f[2], f[3]}; *(f32x4*)(dst + 4) = (f32x4){f[4], f[5], f[6], f[7]};
                }
                *(LAS u32x4*)(lds + (piece >> 4) * 32768 + off_b((unsigned)j, (unsigned)(piece & 15))) = pack8(f);
            }
        }
        __syncthreads();
        if (ui + 1 < nAll) { const int chn = GATE_CH(ui + 1); GATE_PREFETCH(chn); }
        if (samp) gate_unit<true>(wl, bsl, z, r0, g, img, lane, wv);
        else gate_unit<false>(wl, bsl, z, r0, g, img, lane, wv);
        __syncthreads();
    }
#undef GATE_PREFETCH
#undef GATE_CH
}

#define XB_TMO      128
#define XB_XCNT(j)  (256  + 64 * (j))
#define XB_XSUB(j)  (1280 + 64 * (j))
#define XB_XGEN(j)  (2304 + 64 * (j))
#define XB_TOP      3328
#define XB_TOPGEN   3392
#define XCD_BAR_WORDS 3456
#define XB_SPIN_CAP (1u << 18)

__device__ __forceinline__ unsigned xb_ld(unsigned* p)              { return __hip_atomic_load(p, __ATOMIC_RELAXED, __HIP_MEMORY_SCOPE_AGENT); }
__device__ __forceinline__ unsigned xb_add(unsigned* p, unsigned v) { return __hip_atomic_fetch_add(p, v, __ATOMIC_RELAXED, __HIP_MEMORY_SCOPE_AGENT); }
__device__ __forceinline__ unsigned xb_xcc_id() { return (unsigned)__builtin_amdgcn_s_getreg((3 << 11) | 20) & 0xFu; }
#define XB_SPIN(cond, bar) do { unsigned _sp = 0; while (cond) { __builtin_amdgcn_s_sleep(1); \
    if ((++_sp & 255u) == 0u) { if (xb_ld(&(bar)[XB_TMO])) break; if (_sp > XB_SPIN_CAP) { atomicAdd(&(bar)[XB_TMO], 1u); break; } } } } while (0)

struct XcdBarrier {
    unsigned* bar; unsigned x;
    volatile LAS unsigned* st;
};

__device__ __forceinline__ XcdBarrier xcd_barrier_post(unsigned* bar, volatile LAS unsigned* st) {
    XcdBarrier b; b.bar = bar; b.x = xb_xcc_id(); b.st = st;
    if (threadIdx.x == 0) (void)xb_add(&bar[XB_XCNT(b.x)], 1u);
    return b;
}
__device__ __forceinline__ void xcd_barrier_complete(unsigned* bar, unsigned x, unsigned& nloc, unsigned& nx) {
    const unsigned G = gridDim.x * gridDim.y * gridDim.z;
    unsigned sum, cnt, mine, sp = 0u;
    for (;;) {
        sum = 0u; cnt = 0u; mine = 0u;
#pragma unroll
        for (unsigned j = 0; j < 16; ++j) { const unsigned c = xb_ld(&bar[XB_XCNT(j)]); sum += c; cnt += (c > 0u) ? 1u : 0u; mine = (j == x) ? c : mine; }
        if (sum == G) break;
        __builtin_amdgcn_s_sleep(1);
        if ((++sp & 255u) == 0u) { if (xb_ld(&bar[XB_TMO])) break; if (sp > XB_SPIN_CAP) { atomicAdd(&bar[XB_TMO], 1u); break; } }
    }
    nloc = mine > 0u ? mine : 1u; nx = cnt > 0u ? cnt : 1u;
}

__device__ __forceinline__ void xcd_barrier(const XcdBarrier& b) {
    asm volatile("s_waitcnt vmcnt(0)" ::: "memory");
    __syncthreads();
    if (threadIdx.x == 0) {
        unsigned* bar = b.bar;
        __builtin_amdgcn_s_waitcnt(0);
        unsigned nloc = b.st[0], nx = b.st[1];
        if (nloc == 0u) { xcd_barrier_complete(bar, b.x, nloc, nx); b.st[0] = nloc; b.st[1] = nx; }
        const unsigned old = xb_add(&bar[XB_XSUB(b.x)], 1u);
        const unsigned gen = old / nloc;
        if (old + 1u == (gen + 1u) * nloc) {
            __builtin_amdgcn_fence(__ATOMIC_RELEASE, "agent");
            asm volatile("s_waitcnt vmcnt(0)" ::: "memory");
            const unsigned og = xb_add(&bar[XB_TOP], 1u);
            const unsigned tg = og / nx;
            if (og + 1u == (tg + 1u) * nx) xb_add(&bar[XB_TOPGEN], 1u);
            else XB_SPIN(xb_ld(&bar[XB_TOPGEN]) == tg, bar);
            __builtin_amdgcn_fence(__ATOMIC_ACQUIRE, "agent");
            xb_add(&bar[XB_XGEN(b.x)], 1u);
            asm volatile("s_waitcnt vmcnt(0)" ::: "memory");
        } else {
            XB_SPIN(xb_ld(&bar[XB_XGEN(b.x)]) == gen, bar);
            __builtin_amdgcn_fence(__ATOMIC_ACQUIRE, "agent");
            asm volatile("s_waitcnt vmcnt(0)" ::: "memory");
        }
    }
    __syncthreads();
}


__global__ void __launch_bounds__(512, 2) mega(Params P) {
    extern __shared__ __attribute__((aligned(16))) unsigned char lds_raw[];
    cg::grid_group grid = cg::this_grid();
    LAS unsigned char* lds = (LAS unsigned char*)lds_raw;
    bf16_t* hbuf = (bf16_t*)(P.ws + WS_H); bf16_t* zbuf = (bf16_t*)(P.ws + WS_Z); bf16_t* mixbuf = (bf16_t*)(P.ws + WS_MIX);
    const int G = gridDim.x;
    if (threadIdx.x < 4) ((LAS unsigned*)(lds + LDS_BARW))[threadIdx.x] = 0u;
    __syncthreads();
    const XcdBarrier xbar = xcd_barrier_post((unsigned*)(P.ws + WS_BAR), (volatile LAS unsigned*)(lds + LDS_BARW));
    unsigned* cen = (unsigned*)(P.ws + WS_CEN);
    if (threadIdx.x == 0) ((LAS unsigned*)(lds + LDS_BARW))[2] = __hip_atomic_fetch_add(cen + 64 * xbar.x, 1u, __ATOMIC_RELAXED, __HIP_MEMORY_SCOPE_AGENT);

    mod_phase(P, (LAS float*)lds);
    convert_phase(P, (LAS float*)lds);
    grid.sync();
    int bid = blockIdx.x;
    {
        bool even = true;
#pragma unroll
        for (int j = 0; j < 8; ++j) even = even && (__hip_atomic_load(cen + 64 * j, __ATOMIC_RELAXED, __HIP_MEMORY_SCOPE_AGENT) == (unsigned)(G >> 3));
        const unsigned rank = ((LAS unsigned*)(lds + LDS_BARW))[2];
        if (even && (G & 7) == 0 && xbar.x < 8u) bid = (int)(xbar.x + 8u * rank);
    }
    resnorm_phase(P, 0, 0, 0);
    xcd_barrier(xbar);
#pragma unroll 1
    for (int li = 0; li < 4; ++li) {
        const int jl = li >> 1;
        pg8::Gemm gm; const float* scale = nullptr;
        if ((li & 1) == 0) {
            {
                pg8::Gemm g{hbuf, (const bf16_t*)(P.ws + WS_WIN) + (size_t)jl * 4096 * 1024, MP, 4096, 1024, 1024, 0};
                sgemm_wide<0>(g.A, g.Bt, zbuf);
                pg8::StaticOrder S; S.init(MP, 4096, G, bid);
                EpiAct<0> E{zbuf, 4096, (float*)(P.ws + WS_VSS), nullptr};
                pg8::gemm_phase<EpiAct<0>, pg8::StaticOrder>(lds, g, S, E);
            }
            xcd_barrier(xbar);
            gate_phase(P, jl, lds);
            xcd_barrier(xbar);
            gm = pg8::Gemm{zbuf, (const bf16_t*)(P.ws + WS_WOUT) + (size_t)jl * 1024 * 2048, MP, 1024, 2048, 4096, 0};
        } else {
            pool_phase(P, jl);
            xcd_barrier(xbar);
            gm = pg8::Gemm{zbuf, (const bf16_t*)(P.ws + WS_WPOOL) + (size_t)jl * 1024 * 256, MP, 1024, 256, 1024, 256};
            scale = P.in[14] + jl * 1024;
        }
#pragma unroll 1
        for (int pass = 0; pass < 2; ++pass) {
            {
                sgemm_phase<2>((LAS float*)lds, gm.A, gm.lda, gm.acol, gm.Bt, gm.N, gm.K, mixbuf, 1024, scale);
                pg8::StaticOrder S; S.init(MP, 1024, G, bid);
                EpiAct<2> E{mixbuf, 1024, nullptr, scale};
                pg8::gemm_phase<EpiAct<2>, pg8::StaticOrder>(lds, gm, S, E);
            }
            xcd_barrier(xbar);
            resnorm_phase(P, li, pass + 1, 0);
            xcd_barrier(xbar);
            if (pass == 0) {
                {
                    pg8::Gemm g{hbuf, (const bf16_t*)(P.ws + WS_WUP) + (size_t)li * 4096 * 1024, MP, 4096, 1024, 1024, 0};
                    sgemm_wide<1>(g.A, g.Bt, zbuf);
                    pg8::StaticOrder S; S.init(MP, 4096, G, bid);
                    EpiAct<1> E{zbuf, 4096, nullptr, nullptr};
                    pg8::gemm_phase<EpiAct<1>, pg8::StaticOrder>(lds, g, S, E);
                }
                xcd_barrier(xbar);
                gm = pg8::Gemm{zbuf, (const bf16_t*)(P.ws + WS_WDOWN) + (size_t)li * 1024 * 4096, MP, 1024, 4096, 4096, 0};
                scale = nullptr;
            }
        }
    }
}

extern "C" void kernel_launch(void* const* d_in, const int* in_sizes, int n_in, void* d_out, int out_size, void* d_ws, size_t ws_size, hipStream_t stream) {
    static int grid = 0;
    if (grid == 0) {
        if (n_in != 17 || ws_size < WS_END) { fprintf(stderr, "kernel_launch: unexpected n_in %d / ws_size %zu (need %zu)\n", n_in, ws_size, (size_t)WS_END); grid = -1; return; }
        int dev = 0, cus = 0, per_cu = 0;
        hipGetDevice(&dev);
        hipDeviceGetAttribute(&cus, hipDeviceAttributeMultiprocessorCount, dev);
        if (hipFuncSetAttribute((const void*)mega, hipFuncAttributeMaxDynamicSharedMemorySize, LDS_BYTES) != hipSuccess) { fprintf(stderr, "kernel_launch: hipFuncSetAttribute failed\n"); grid = -1; return; }
        if (hipOccupancyMaxActiveBlocksPerMultiprocessor(&per_cu, (const void*)mega, 512, LDS_BYTES) != hipSuccess || per_cu < 1) { fprintf(stderr, "kernel_launch: occupancy query gave %d\n", per_cu); per_cu = 1; (void)hipGetLastError(); }
        grid = (cus * per_cu) & ~7;
        if (grid < 8) { grid = -1; return; }
    }
    if (grid < 0) return;
    Params p{};
    for (int i = 0; i < 17; ++i) p.in[i] = (const float*)d_in[i];
    p.out = (float*)d_out; p.ws = (unsigned char*)d_ws;
    if (hipMemsetAsync((char*)d_ws + WS_BAR, 0, 16384 + 4096, stream) != hipSuccess) { fprintf(stderr, "kernel_launch: memset of barrier words failed\n"); return; }
    void* args[] = {&p};
    hipError_t e = hipLaunchCooperativeKernel((const void*)mega, dim3(grid), dim3(512), args, LDS_BYTES, stream);
    if (e != hipSuccess) fprintf(stderr, "cooperative launch failed: %s (grid %d)\n", hipGetErrorString(e), grid);
}
```
